# Optimizing an MI355X kernel written in HIP

```python
import jax, jax.numpy as jnp
from jax import lax
import numpy as np

D_MODEL = 2048
BATCH = 2
SEQ = 8192
DEPTH = 2

MIX_WIDTH = D_MODEL
GROUP_WIDTH = MIX_WIDTH // 2
ATT_HEADS = 8
ATT_KV_HEADS = 2
ATT_HEAD_DIM = GROUP_WIDTH // ATT_HEADS
ATT_WINDOW = 128
ATT_BLOCK = 128
ROPE_THETA = 10000.0
ML_HEADS = 4
ML_V_DIM = GROUP_WIDTH // ML_HEADS
ML_QK_DIM = ML_V_DIM // 2
ML_CHUNK = 128
CONV_WIDTH = 3
M_INIT = -1e30
D_FF = 4 * D_MODEL
NORM_EPS = 1e-6

ATT_Q_COLS = ATT_HEADS * ATT_HEAD_DIM
ATT_KV_COLS = ATT_KV_HEADS * ATT_HEAD_DIM
ML_QK_COLS = ML_HEADS * ML_QK_DIM
ML_V_COLS = ML_HEADS * ML_V_DIM
GATE_COLS = 4 * ML_HEADS
IN_COLS = ATT_Q_COLS + 2 * ATT_KV_COLS + 2 * ML_QK_COLS + 2 * ML_V_COLS + GATE_COLS

kernel_name = "hymba_style_swa_mlstm_encoder"


def rms_norm(x, g):
    xf = x.astype(jnp.float32)
    y = xf * lax.rsqrt(jnp.mean(xf * xf, axis=-1, keepdims=True) + NORM_EPS)
    return (y * g.astype(jnp.float32)).astype(x.dtype)


def rope(x, pos):
    half = x.shape[-1] // 2
    inv_freq = ROPE_THETA ** (-jnp.arange(half, dtype=jnp.float32) / half)
    ang = pos.astype(jnp.float32)[:, None] * inv_freq[None, :]
    cos = jnp.cos(ang)[None, :, None, :]
    sin = jnp.sin(ang)[None, :, None, :]
    xf = x.astype(jnp.float32)
    x1, x2 = xf[..., :half], xf[..., half:]
    return jnp.concatenate([x1 * cos - x2 * sin, x2 * cos + x1 * sin], axis=-1).astype(x.dtype)


def window_attention(q, k, v, sink):
    B, S, Hq, D = q.shape
    Hkv = k.shape[2]
    G = Hq // Hkv
    W = ATT_BLOCK
    NB = S // W
    pos = jnp.arange(S)
    q = rope(q, pos)
    k = rope(k, pos)
    pad = ((0, 0), (W, W), (0, 0), (0, 0))
    kb = jnp.pad(k, pad).reshape(B, NB + 2, W, Hkv, D)
    vb = jnp.pad(v, pad).reshape(B, NB + 2, W, Hkv, D)
    kwin = jnp.concatenate([kb[:, :-2], kb[:, 1:-1], kb[:, 2:]], axis=2)
    vwin = jnp.concatenate([vb[:, :-2], vb[:, 1:-1], vb[:, 2:]], axis=2)
    qb = q.reshape(B, NB, W, Hkv, G, D)
    s = jnp.einsum('bnqhgd,bnkhd->bnhgqk', qb, kwin).astype(jnp.float32) * (D ** -0.5)
    qi = jnp.arange(W)[:, None]
    kj = jnp.arange(3 * W)[None, :]
    band = jnp.abs(kj - qi - W) <= ATT_WINDOW
    key_pos = jnp.arange(NB)[:, None] * W - W + jnp.arange(3 * W)[None, :]
    in_range = (key_pos >= 0) & (key_pos < S)
    mask = band[None, :, :] & in_range[:, None, :]
    s = jnp.where(mask[None, :, None, None], s, -jnp.inf)
    sink_f = sink.astype(jnp.float32).reshape(Hkv, G)[None, None, :, :, None, None]
    m = jnp.maximum(jnp.max(s, axis=-1, keepdims=True), sink_f)
    p = jnp.exp(s - m)
    p = p / (jnp.sum(p, axis=-1, keepdims=True) + jnp.exp(sink_f - m))
    o = jnp.einsum('bnhgqk,bnkhd->bnqhgd', p.astype(v.dtype), vwin)
    return o.reshape(B, S, Hq * D)


def mlstm_chunkwise(q, k, v, log_i, log_f):
    B, H, S, dk = q.shape
    dv = v.shape[-1]
    L = ML_CHUNK
    NC = S // L
    qc = q.reshape(B, H, NC, L, dk)
    kc = k.reshape(B, H, NC, L, dk)
    vc = v.reshape(B, H, NC, L, dv)
    li = log_i.reshape(B, H, NC, L)
    b = jnp.cumsum(log_f.reshape(B, H, NC, L), axis=-1)
    g = b[..., -1]
    a = g[..., None] - b + li
    m_loc = jnp.max(a, axis=-1)
    w_end = jnp.exp(a - m_loc[..., None])
    C_loc = jnp.einsum('bhcld,bhcle->bhcde', w_end[..., None] * kc, vc)
    n_loc = jnp.einsum('bhcl,bhcld->bhcd', w_end, kc)

    def step(carry, xs):
        C, n, m = carry
        g_c, m_l, C_l, n_l = xs
        m_new = jnp.maximum(g_c + m, m_l)
        s_prev = jnp.exp(g_c + m - m_new)
        s_loc = jnp.exp(m_l - m_new)
        C_new = s_prev[..., None, None] * C + s_loc[..., None, None] * C_l
        n_new = s_prev[..., None] * n + s_loc[..., None] * n_l
        return (C_new, n_new, m_new), (C, n, m)

    init = (jnp.zeros((B, H, dk, dv), jnp.float32),
            jnp.zeros((B, H, dk), jnp.float32),
            jnp.full((B, H), M_INIT, jnp.float32))
    xs = (jnp.moveaxis(g, 2, 0), jnp.moveaxis(m_loc, 2, 0),
          jnp.moveaxis(C_loc, 2, 0), jnp.moveaxis(n_loc, 2, 0))
    _, (C_prev, n_prev, m_prev) = lax.scan(step, init, xs)
    C_prev = jnp.moveaxis(C_prev, 0, 2)
    n_prev = jnp.moveaxis(n_prev, 0, 2)
    m_prev = jnp.moveaxis(m_prev, 0, 2)

    Dm = b[..., :, None] - b[..., None, :] + li[..., None, :]
    lower = jnp.tril(jnp.ones((L, L), dtype=bool))
    Dm = jnp.where(lower, Dm, -jnp.inf)
    inter = b + m_prev[..., None]
    m_t = jnp.maximum(inter, jnp.max(Dm, axis=-1))
    sc = jnp.einsum('bhctd,bhcsd->bhcts', qc, kc) * jnp.exp(Dm - m_t[..., None])
    w_inter = jnp.exp(inter - m_t)
    num = (jnp.einsum('bhcts,bhcse->bhcte', sc, vc)
           + w_inter[..., None] * jnp.einsum('bhctd,bhcde->bhcte', qc, C_prev))
    den = jnp.sum(sc, axis=-1) + w_inter * jnp.einsum('bhctd,bhcd->bhct', qc, n_prev)
    h = num / jnp.maximum(jnp.abs(den), jnp.exp(-m_t))[..., None]
    return h.reshape(B, H, S, dv)


def centred_depthwise_conv(x, w):
    K = w.shape[0]
    r = K // 2
    S = x.shape[1]
    xp = jnp.pad(x, ((0, 0), (r, r), (0, 0)))
    y = xp[:, 0:S] * w[0]
    for j in range(1, K):
        y = y + xp[:, j:j + S] * w[j]
    return y


def mlstm_mixer(mq, mk, mv, mo, gate_pre, conv_w, gate_bias, head_norm_g):
    B, S, _ = mq.shape
    qk = jax.nn.silu(centred_depthwise_conv(jnp.concatenate([mq, mk], axis=-1), conv_w))
    q, k = qk[..., :ML_QK_COLS], qk[..., ML_QK_COLS:]
    q = q.reshape(B, S, ML_HEADS, ML_QK_DIM).transpose(0, 2, 1, 3).astype(jnp.float32) * (ML_QK_DIM ** -0.5)
    k = k.reshape(B, S, ML_HEADS, ML_QK_DIM).transpose(0, 2, 1, 3).astype(jnp.float32)
    v = mv.reshape(B, S, ML_HEADS, ML_V_DIM).transpose(0, 2, 1, 3).astype(jnp.float32)
    gates = (gate_pre.astype(jnp.float32) + gate_bias.astype(jnp.float32)).reshape(B, S, 4, ML_HEADS)
    gates = jnp.transpose(gates, (2, 0, 3, 1))
    i_fwd, f_fwd, i_bwd, f_bwd = gates[0], gates[1], gates[2], gates[3]
    h_fwd = mlstm_chunkwise(q, k, v, i_fwd, jax.nn.log_sigmoid(f_fwd))
    flip = lambda t: jnp.flip(t, axis=2)
    h_bwd = flip(mlstm_chunkwise(flip(q), flip(k), flip(v), flip(i_bwd),
                                 jax.nn.log_sigmoid(flip(f_bwd))))
    h = (h_fwd + h_bwd).transpose(0, 2, 1, 3)
    h = h * lax.rsqrt(jnp.mean(h * h, axis=-1, keepdims=True) + NORM_EPS)
    h = h.reshape(B, S, ML_V_COLS) * head_norm_g.astype(jnp.float32)
    out = h * jax.nn.sigmoid(mo.astype(jnp.float32))
    return out.astype(mq.dtype)


def hybrid_layer(x, w_in, conv_w, gate_bias, ml_norm_g, attn_sink, w_out,
                 g_pre_mix, g_post_mix, g_pre_mlp, g_post_mlp, w_up, w_down):
    B, S, _ = x.shape
    h = rms_norm(x, g_pre_mix)
    proj = h @ w_in
    sizes = [ATT_Q_COLS, ATT_KV_COLS, ATT_KV_COLS, ML_QK_COLS, ML_QK_COLS, ML_V_COLS, ML_V_COLS]
    cuts = []
    acc = 0
    for sz in sizes:
        acc += sz
        cuts.append(acc)
    aq, ak, av, mq, mk, mv, mo, mg = jnp.split(proj, cuts, axis=-1)
    att = window_attention(aq.reshape(B, S, ATT_HEADS, ATT_HEAD_DIM),
                           ak.reshape(B, S, ATT_KV_HEADS, ATT_HEAD_DIM),
                           av.reshape(B, S, ATT_KV_HEADS, ATT_HEAD_DIM),
                           attn_sink)
    mem = mlstm_mixer(mq, mk, mv, mo, mg, conv_w, gate_bias, ml_norm_g)
    mix = jnp.concatenate([att, mem.astype(att.dtype)], axis=-1) @ w_out
    x = x + rms_norm(mix, g_post_mix)
    h = rms_norm(x, g_pre_mlp)
    u = jnp.square(jax.nn.relu(h @ w_up))
    x = x + rms_norm(u @ w_down, g_post_mlp)
    return x


def setup_inputs(seed: int = 0) -> dict:
    key = jax.random.key(seed)
    ks = jax.random.split(key, 16)
    f32 = jnp.float32
    x = jax.random.normal(ks[0], (BATCH, SEQ, D_MODEL), f32)
    w_in = jax.random.normal(ks[1], (DEPTH, D_MODEL, IN_COLS), f32) * D_MODEL ** -0.5
    conv_w = jax.random.normal(ks[2], (DEPTH, CONV_WIDTH, 2 * ML_QK_COLS), f32) * CONV_WIDTH ** -0.5
    gk = jax.random.split(ks[3], 4)
    i_bias = 0.1 * jax.random.normal(gk[0], (DEPTH, 2, ML_HEADS), f32)
    f_bias = (jnp.linspace(3.0, 6.0, ML_HEADS, dtype=f32)[None, None, :]
              + 0.1 * jax.random.normal(gk[1], (DEPTH, 2, ML_HEADS), f32))
    gate_bias = jnp.stack([i_bias[:, 0], f_bias[:, 0], i_bias[:, 1], f_bias[:, 1]], axis=1).reshape(DEPTH, GATE_COLS)
    ml_norm_g = 1.0 + 0.05 * jax.random.normal(ks[4], (DEPTH, ML_V_COLS), f32)
    attn_sink = 0.5 * jax.random.normal(ks[5], (DEPTH, ATT_HEADS), f32)
    w_out = jax.random.normal(ks[6], (DEPTH, MIX_WIDTH, D_MODEL), f32) * MIX_WIDTH ** -0.5
    g_pre_mix = 1.0 + 0.05 * jax.random.normal(ks[7], (DEPTH, D_MODEL), f32)
    g_post_mix = 1.0 + 0.05 * jax.random.normal(ks[8], (DEPTH, D_MODEL), f32)
    g_pre_mlp = 1.0 + 0.05 * jax.random.normal(ks[9], (DEPTH, D_MODEL), f32)
    g_post_mlp = 1.0 + 0.05 * jax.random.normal(ks[10], (DEPTH, D_MODEL), f32)
    w_up = jax.random.normal(ks[11], (DEPTH, D_MODEL, D_FF), f32) * D_MODEL ** -0.5
    w_down = jax.random.normal(ks[12], (DEPTH, D_FF, D_MODEL), f32) * D_FF ** -0.5
    return {"x": x, "w_in": w_in, "conv_w": conv_w, "gate_bias": gate_bias,
            "ml_norm_g": ml_norm_g, "attn_sink": attn_sink, "w_out": w_out,
            "g_pre_mix": g_pre_mix, "g_post_mix": g_post_mix,
            "g_pre_mlp": g_pre_mlp, "g_post_mlp": g_post_mlp,
            "w_up": w_up, "w_down": w_down}


def reference(x, w_in, conv_w, gate_bias, ml_norm_g, attn_sink, w_out,
              g_pre_mix, g_post_mix, g_pre_mlp, g_post_mlp, w_up, w_down):
    for l in range(DEPTH):
        x = hybrid_layer(x, w_in[l], conv_w[l], gate_bias[l], ml_norm_g[l], attn_sink[l], w_out[l],
                         g_pre_mix[l], g_post_mix[l], g_pre_mlp[l], g_post_mlp[l], w_up[l], w_down[l])
    return x
```

```cpp
#include <hip/hip_runtime.h>
#include <hip/hip_cooperative_groups.h>
#include <cstdio>
#include <cstdint>
namespace cg = cooperative_groups;

#ifndef PHMASK
#define PHMASK 0xFFFF
#endif
#ifndef ONE_LAUNCH
#define ONE_LAUNCH 1
#endif

#define LAS __attribute__((address_space(3)))
typedef unsigned short bf16_t;
typedef short bf16x8 __attribute__((ext_vector_type(8)));
typedef short bf16x4 __attribute__((ext_vector_type(4)));
typedef float f32x4 __attribute__((ext_vector_type(4)));
typedef unsigned u32x4 __attribute__((ext_vector_type(4)));
typedef unsigned u32x2 __attribute__((ext_vector_type(2)));

constexpr int T = 16384, SEQ = 8192, DM = 2048, FF = 8192;
constexpr int INCOLS = 4624;
constexpr int NPROJ = 4608;
constexpr int NIN = 4864;
constexpr int PC_AQ = 0, PC_MO = 1024, PC_AK = 2048, PC_AV = 2304, PC_MQ = 2560, PC_MK = 3072, PC_MV = 3584;
constexpr float NORM_EPS = 1e-6f;
constexpr int NPH = 21;
constexpr int LDS_BYTES = 163840;

constexpr size_t WS_U = 0;
constexpr size_t WS_PROJ = 0;
constexpr size_t WS_QC = 150994944;
constexpr size_t WS_KC = WS_QC + 16777216;
constexpr size_t WS_CB = WS_KC + 16777216;
constexpr size_t WS_GATES = WS_CB + 67108864;
constexpr size_t WS_NB = WS_GATES + 1048576;
constexpr size_t WS_ML = WS_NB + 524288;
constexpr size_t WS_GC = WS_ML + 4096;
constexpr size_t WS_MP = WS_GC + 4096;
constexpr size_t WS_MIXO = 268435456;
constexpr size_t WS_HB = WS_MIXO + 67108864;
constexpr size_t WS_W0 = WS_HB + 67108864;
constexpr size_t WS_W1 = WS_W0 + 33554432;
constexpr size_t WS_W2 = WS_W1 + 33554432;
constexpr size_t WS_BAR = WS_W2 + 8388608;
constexpr size_t WS_END = WS_BAR + 16384;
static_assert(WS_MP + 4096 <= WS_MIXO, "overlay");

typedef __bf16 bf16v2_t __attribute__((ext_vector_type(2)));
typedef float f32x2_t __attribute__((ext_vector_type(2)));
__device__ __forceinline__ unsigned cvt_pk_bf16(float lo, float hi) { const f32x2_t v = {lo, hi}; const bf16v2_t b = __builtin_convertvector(v, bf16v2_t); return __builtin_bit_cast(unsigned, b); }
__device__ __forceinline__ bf16_t f2bf(float x) { return (bf16_t)(cvt_pk_bf16(x, 0.f) & 0xffffu); }
__device__ __forceinline__ float bf2f(bf16_t b) { return __uint_as_float(((unsigned)b) << 16); }
__device__ __forceinline__ float bflo(unsigned w) { return __uint_as_float(w << 16); }
__device__ __forceinline__ float bfhi(unsigned w) { return __uint_as_float(w & 0xffff0000u); }
__device__ __forceinline__ float wave_sum(float v) {
#pragma unroll
    for (int o = 1; o < 64; o <<= 1) v += __shfl_xor(v, o);
    return v;
}
__device__ __forceinline__ float sigmoidf_(float y) { return 1.0f / (1.0f + __expf(-y)); }
__device__ __forceinline__ float logsigmoid_(float x) { return x < 0.f ? x - log1pf(expf(x)) : -log1pf(expf(-x)); }
#define MFMA16(a, b, c) __builtin_amdgcn_mfma_f32_16x16x32_bf16((a), (b), (c), 0, 0, 0)
#define LGKM0() asm volatile("s_waitcnt lgkmcnt(0)" ::: "memory")

namespace pg8 {
constexpr int BM = 256, BK = 64, HALF = 128, HTB = HALF * BK * 2, STAGE_BYTES = 8 * HTB, NXCD = 8, WGM = 8;
__host__ __device__ __forceinline__ int lds_byte(int r, int c) { const int st = (r >> 4) * 2 + (c >> 5), rr = r & 15, cc = c & 31, ob = rr * 64 + cc * 2; return st * 1024 + (ob ^ (((ob >> 9) & 1) << 5)); }
__host__ __device__ __forceinline__ void stage_rc(int b, int& R, int& C) { const int st = b / 1024, sb = b % 1024, swz = sb ^ (((sb >> 9) & 1) << 5); R = (st >> 1) * 16 + swz / 64; C = (st & 1) * 32 + (swz % 64) / 2; }
__host__ __device__ __forceinline__ int perm32(int rho) { const int n = rho >> 4, i = rho & 15; return 8 * (i >> 2) + 4 * n + (i & 3); }

struct Unit { int pm, pn; };
struct Gemm { const bf16_t* A; const bf16_t* Bt; int M, N, K, lda; };

struct StaticOrder {
    int nM, nN, nwg, G, c;
    __device__ void init(int M, int N, int G_, int c_) { nM = M / BM; nN = N / BM; nwg = nM * nN; G = G_; c = c_; }
    __device__ bool next(int i, Unit& u) const {
        const long L = (long)i * G + c; if (L >= nwg) return false;
        int wgid = (int)L; { const int q = nwg / NXCD, r = nwg % NXCD, xcd = wgid % NXCD, off = wgid / NXCD; wgid = (xcd < r ? xcd * (q + 1) : r * (q + 1) + (xcd - r) * q) + off; }
        const int nig = WGM * nN, gid = wgid / nig, fm = gid * WGM, gsz = (nM - fm) < WGM ? (nM - fm) : WGM;
        u.pm = fm + ((wgid % nig) % gsz); u.pn = (wgid % nig) / gsz; return true;
    }
};

struct Epi {
    bf16_t* O; int ldc; int act; float* gates; int gate_pn;
    __device__ __forceinline__ void operator()(const f32x4 (&acc)[2][2][4][2], const Unit& u, int wr, int wc, int fr, int fq) const {
        const int row0 = u.pm * BM + wr * 64 + fr;
        if (u.pn == gate_pn) {
            if (wc == 0 && fq < 2) {
#pragma unroll
                for (int ai = 0; ai < 2; ++ai)
#pragma unroll
                    for (int m = 0; m < 4; ++m) { float* gp = gates + (size_t)(row0 + ai * HALF + m * 16) * 16 + 8 * fq;
#pragma unroll
                        for (int n = 0; n < 2; ++n) *(f32x4*)(gp + 4 * n) = acc[ai][0][m][n]; }
            }
            return;
        }
        const int col0 = u.pn * BM + wc * 32 + 8 * fq;
#pragma unroll
        for (int ai = 0; ai < 2; ++ai)
#pragma unroll
            for (int m = 0; m < 4; ++m) { bf16_t* rowp = O + (size_t)(row0 + ai * HALF + m * 16) * ldc + col0;
#pragma unroll
                for (int bj = 0; bj < 2; ++bj) { f32x4 v0 = acc[ai][bj][m][0], v1 = acc[ai][bj][m][1];
                    if (act) {
#pragma unroll
                        for (int j = 0; j < 4; ++j) { const float a = fmaxf(v0[j], 0.f), b = fmaxf(v1[j], 0.f); v0[j] = a * a; v1[j] = b * b; } }
                    u32x4 w; w.x = cvt_pk_bf16(v0[0], v0[1]); w.y = cvt_pk_bf16(v0[2], v0[3]); w.z = cvt_pk_bf16(v1[0], v1[1]); w.w = cvt_pk_bf16(v1[2], v1[3]);
                    if (act) __builtin_nontemporal_store(w, (u32x4*)(rowp + bj * HALF)); else *(u32x4*)(rowp + bj * HALF) = w; } }
    }
};

__device__ __forceinline__ void gemm_phase(LAS unsigned char* lds, const Gemm g, const StaticOrder& S, const Epi& E, const int tid) {
    const int wid = __builtin_amdgcn_readfirstlane(tid >> 6), lane = tid & 63, wr = wid >> 2, wc = wid & 3, fr = lane & 15, fq = lane >> 4;
    const int K = g.K, nt = K / BK, lda = g.lda;
    unsigned voffA[2], voffB[2];
#pragma unroll
    for (int i = 0; i < 2; ++i) { int R, C; stage_rc(tid * 16 + i * 8192, R, C); const int Rb = (R & ~31) + perm32(R & 31);
        voffA[i] = (unsigned)(R * lda + C) * 2u; voffB[i] = (unsigned)(Rb * K + C) * 2u; }
    const size_t kstep = (size_t)(BK * 2);
    const size_t hstepA = (size_t)HALF * lda * 2, hstepB = (size_t)HALF * K * 2;
    const size_t tstepA = 2 * hstepA, tstepB = 2 * hstepB;
    const unsigned ldsw = (unsigned)wid * 1024u;
    const int aoff = lds_byte(wr * 64 + fr, fq * 8), boff = lds_byte(wc * 32 + fr, fq * 8);
#define PG8_SA(b, h) (((b) * 2 + (h)) * HTB)
#define PG8_SB(b, h) ((4 + (b) * 2 + (h)) * HTB)
#define PG8_STAGE(bufoff, gbase, voff) do { _Pragma("unroll") for (int _i = 0; _i < 2; ++_i) \
        __builtin_amdgcn_global_load_lds((const unsigned*)((const char*)(gbase) + (voff)[_i]), (LAS unsigned*)(lds + (bufoff) + ldsw + _i * 8192), 16, 0, 0); } while (0)
#define PG8_LDA(dst, b, h) do { _Pragma("unroll") for (int m = 0; m < 4; ++m) _Pragma("unroll") for (int k = 0; k < 2; ++k) dst[m][k] = *(const LAS bf16x8*)(lds + PG8_SA(b, h) + aoff + m * 2048 + k * 1024); } while (0)
#define PG8_LDB(dst, b, h) do { _Pragma("unroll") for (int n = 0; n < 2; ++n) _Pragma("unroll") for (int k = 0; k < 2; ++k) dst[n][k] = *(const LAS bf16x8*)(lds + PG8_SB(b, h) + boff + n * 2048 + k * 1024); } while (0)
#define PG8_MMA(ai, bj, At, Bt) do { __builtin_amdgcn_s_setprio(1); _Pragma("unroll") for (int m = 0; m < 4; ++m) _Pragma("unroll") for (int n = 0; n < 2; ++n) _Pragma("unroll") for (int k = 0; k < 2; ++k) \
        acc[ai][bj][m][n] = __builtin_amdgcn_mfma_f32_16x16x32_bf16(Bt[n][k], At[m][k], acc[ai][bj][m][n], 0, 0, 0); __builtin_amdgcn_s_setprio(0); } while (0)
#define PG8_WAIT_V(n) asm volatile("s_waitcnt vmcnt(" #n ")" ::: "memory")
#define PG8_WAIT_L(n) asm volatile("s_waitcnt lgkmcnt(" #n ")" ::: "memory")
#define PG8_BAR __builtin_amdgcn_s_barrier()
#define PG8_SCHED __builtin_amdgcn_sched_barrier(0)
    Unit cur, nxt; int ui = 0;
    if (!S.next(0, cur)) return;
    f32x4 acc[2][2][4][2];
#pragma unroll
    for (int a = 0; a < 2; ++a)
#pragma unroll
        for (int b = 0; b < 2; ++b)
#pragma unroll
            for (int m = 0; m < 4; ++m)
#pragma unroll
                for (int n = 0; n < 2; ++n) acc[a][b][m][n] = (f32x4){0.f, 0.f, 0.f, 0.f};
    bf16x8 At[4][2], B0[2][2], B1[2][2];
    const char* cA = (const char*)g.A + (size_t)cur.pm * tstepA; const char* cB = (const char*)g.Bt + (size_t)cur.pn * tstepB;
    PG8_STAGE(PG8_SB(0, 0), cB, voffB); PG8_STAGE(PG8_SB(0, 1), cB + hstepB, voffB); PG8_STAGE(PG8_SA(0, 0), cA, voffA); PG8_STAGE(PG8_SA(0, 1), cA + hstepA, voffA);
    if (wr == 1) PG8_BAR;
    PG8_WAIT_V(2); PG8_BAR;
    PG8_STAGE(PG8_SB(1, 0), cB + kstep, voffB); PG8_STAGE(PG8_SA(1, 0), cA + kstep, voffA); PG8_STAGE(PG8_SB(1, 1), cB + hstepB + kstep, voffB);
    PG8_WAIT_V(6); PG8_BAR;
    for (;;) {
        const bool has_next = S.next(ui + 1, nxt);
        const char* nA = has_next ? (const char*)g.A + (size_t)nxt.pm * tstepA : cA; const char* nB = has_next ? (const char*)g.Bt + (size_t)nxt.pn * tstepB : cB;
        for (int t = 0; t < nt; t += 2) {
            const bool last = (t == nt - 2);
            const char* a1 = cA + (size_t)(t + 1) * kstep;
            const char* a2 = last ? nA : cA + (size_t)(t + 2) * kstep; const char* b2 = last ? nB : cB + (size_t)(t + 2) * kstep;
            const char* a3 = a2 + kstep; const char* b3 = b2 + kstep;
            PG8_LDB(B0, 0, 0); PG8_LDB(B1, 0, 1); PG8_SCHED; PG8_LDA(At, 0, 0); PG8_STAGE(PG8_SA(1, 1), a1 + hstepA, voffA);
            PG8_WAIT_V(8); PG8_WAIT_L(0); PG8_BAR; PG8_MMA(0, 0, At, B0); PG8_MMA(0, 1, At, B1); PG8_BAR; PG8_SCHED;
            PG8_LDA(At, 0, 1); PG8_STAGE(PG8_SB(0, 0), b2, voffB); PG8_STAGE(PG8_SB(0, 1), b2 + hstepB, voffB); PG8_STAGE(PG8_SA(0, 0), a2, voffA);
            PG8_WAIT_V(8); PG8_WAIT_L(0); PG8_BAR; PG8_MMA(1, 0, At, B0); PG8_MMA(1, 1, At, B1); PG8_BAR; PG8_SCHED;
            PG8_LDB(B0, 1, 0); PG8_LDB(B1, 1, 1); PG8_SCHED; PG8_LDA(At, 1, 0); PG8_STAGE(PG8_SA(0, 1), a2 + hstepA, voffA);
            PG8_WAIT_V(8); PG8_WAIT_L(0); PG8_BAR; PG8_MMA(0, 0, At, B0); PG8_MMA(0, 1, At, B1); PG8_BAR; PG8_SCHED;
            PG8_LDA(At, 1, 1); PG8_STAGE(PG8_SB(1, 0), b3, voffB); PG8_STAGE(PG8_SB(1, 1), b3 + hstepB, voffB); PG8_STAGE(PG8_SA(1, 0), a3, voffA);
            PG8_WAIT_V(8); PG8_WAIT_L(0); PG8_BAR; PG8_MMA(1, 0, At, B0); PG8_MMA(1, 1, At, B1); PG8_BAR; PG8_SCHED;
        }
        if (wr == 0) PG8_BAR;
        E(acc, cur, wr, wc, fr, fq);
        if (!has_next) break;
#pragma unroll
        for (int a = 0; a < 2; ++a)
#pragma unroll
            for (int b = 0; b < 2; ++b)
#pragma unroll
                for (int m = 0; m < 4; ++m)
#pragma unroll
                    for (int n = 0; n < 2; ++n) acc[a][b][m][n] = (f32x4){0.f, 0.f, 0.f, 0.f};
        cur = nxt; cA = nA; cB = nB; ++ui;
        if (wr == 1) PG8_BAR;
    }
    PG8_WAIT_V(0);
    PG8_BAR;
#undef PG8_SA
#undef PG8_SB
#undef PG8_STAGE
#undef PG8_LDA
#undef PG8_LDB
#undef PG8_MMA
#undef PG8_WAIT_V
#undef PG8_WAIT_L
#undef PG8_BAR
#undef PG8_SCHED
}
}

__device__ __forceinline__ void t_load(const float* W, int ldw, int src_n0, int nvalid, int k0, int lane, f32x4 (&v)[16]) {
    const int n4 = lane & 15, kr = lane >> 4;
    const float* wp = W + (size_t)(k0 + kr) * ldw + src_n0 + 4 * n4;
    const bool ok = 4 * n4 < nvalid;
#pragma unroll
    for (int i = 0; i < 16; ++i) { v[i] = (f32x4){0.f, 0.f, 0.f, 0.f}; if (ok) v[i] = __builtin_nontemporal_load((const f32x4*)(wp + (size_t)(4 * i) * ldw)); }
}
__device__ __forceinline__ void t_store(const f32x4 (&v)[16], bf16_t* WT, int K, int dst_n0, int k0, LAS float* scr, int lane) {
    const int n4 = lane & 15, kr = lane >> 4;
#pragma unroll
    for (int i = 0; i < 16; ++i) { LAS float* d = scr + (4 * i + kr) * 65 + 4 * n4; d[0] = v[i][0]; d[1] = v[i][1]; d[2] = v[i][2]; d[3] = v[i][3]; }
    LGKM0();
    const int c8 = lane & 7;
#pragma unroll
    for (int j = 0; j < 8; ++j) { const int n = (lane >> 3) + 8 * j; const LAS float* sp = scr + (8 * c8) * 65 + n;
        u32x4 o; o.x = cvt_pk_bf16(sp[0 * 65], sp[1 * 65]); o.y = cvt_pk_bf16(sp[2 * 65], sp[3 * 65]); o.z = cvt_pk_bf16(sp[4 * 65], sp[5 * 65]); o.w = cvt_pk_bf16(sp[6 * 65], sp[7 * 65]);
        *(u32x4*)(WT + (size_t)(dst_n0 + n) * K + k0 + 8 * c8) = o; }
    LGKM0();
}
__device__ __forceinline__ int in_src_col(int n) {
    if (n < 1024) return n;
    if (n < 2048) return 3584 + (n - 1024);
    if (n < 2304) return 1024 + (n - 2048);
    if (n < 2560) return 1280 + (n - 2304);
    if (n < 3072) return 1536 + (n - 2560);
    if (n < 3584) return 2048 + (n - 3072);
    if (n < 4608) return 2560 + (n - 3584);
    return n;
}
template <bool WIN>
__device__ __forceinline__ void convert_w(const float* W, int K, int N, bf16_t* WT, LAS float* scr, int lane, int gw, int NGW) {
    const int nblk = N / 64, items = (K / 64) * nblk, ldw = WIN ? INCOLS : N;
    int it = gw; if (it >= items) return;
    int k0 = 64 * (it / nblk), n0 = 64 * (it % nblk), src = n0, nvalid = 64;
    if (WIN) { src = in_src_col(n0); nvalid = INCOLS - src; nvalid = nvalid < 0 ? 0 : (nvalid > 64 ? 64 : nvalid); if (n0 < 4608) nvalid = 64; if (nvalid == 0) src = 0; }
    f32x4 v[16];
    t_load(W, ldw, src, nvalid, k0, lane, v);
    for (;;) {
        const int itn = it + NGW; const bool hn = itn < items;
        int k0n = 0, n0n = 0; f32x4 vn[16];
        if (hn) { k0n = 64 * (itn / nblk); n0n = 64 * (itn % nblk); int srcn = n0n, nvn = 64;
            if (WIN) { srcn = in_src_col(n0n); nvn = INCOLS - srcn; nvn = nvn < 0 ? 0 : (nvn > 64 ? 64 : nvn); if (n0n < 4608) nvn = 64; if (nvn == 0) srcn = 0; }
            t_load(W, ldw, srcn, nvn, k0n, lane, vn); }
        t_store(v, WT, K, n0, k0, scr, lane);
        if (!hn) break;
#pragma unroll
        for (int i = 0; i < 16; ++i) v[i] = vn[i];
        it = itn; k0 = k0n; n0 = n0n;
    }
}
__device__ __forceinline__ void convert_plain(const float* W, int K, int N, bf16_t* WT, LAS float* scr, int lane, int gw, int NGW) { convert_w<false>(W, K, N, WT, scr, lane, gw, NGW); }
__device__ __forceinline__ void convert_win(const float* W, bf16_t* WT, LAS float* scr, int lane, int gw, int NGW) { convert_w<true>(W, DM, NIN, WT, scr, lane, gw, NGW); }

__device__ __forceinline__ void row_phase(const float* xf, const bf16_t* xb, const bf16_t* y, const float* gpost, bf16_t* xob, float* xof, const float* gnext, bf16_t* hout, int lane, int gw, int NGW) {
    int m = gw; if (m >= T) return;
    f32x4 v[8]; u32x2 xw[8], yw[8];
    { if (xf) { const f32x4* xr = (const f32x4*)(xf + (size_t)m * DM) + lane;
#pragma unroll
          for (int j = 0; j < 8; ++j) v[j] = __builtin_nontemporal_load(xr + 64 * j); }
      else { const u32x2* xr = (const u32x2*)(xb + (size_t)m * DM) + lane;
#pragma unroll
          for (int j = 0; j < 8; ++j) xw[j] = __builtin_nontemporal_load(xr + 64 * j); }
      if (y) { const u32x2* yr = (const u32x2*)(y + (size_t)m * DM) + lane;
#pragma unroll
          for (int j = 0; j < 8; ++j) yw[j] = __builtin_nontemporal_load(yr + 64 * j); } }
    for (;;) {
        const int mn = m + NGW; const bool hn = mn < T;
        f32x4 vn[8]; u32x2 xwn[8], ywn[8];
        if (hn) {
            if (xf) { const f32x4* xr = (const f32x4*)(xf + (size_t)mn * DM) + lane;
#pragma unroll
                for (int j = 0; j < 8; ++j) vn[j] = __builtin_nontemporal_load(xr + 64 * j); }
            else { const u32x2* xr = (const u32x2*)(xb + (size_t)mn * DM) + lane;
#pragma unroll
                for (int j = 0; j < 8; ++j) xwn[j] = __builtin_nontemporal_load(xr + 64 * j); }
            if (y) { const u32x2* yr = (const u32x2*)(y + (size_t)mn * DM) + lane;
#pragma unroll
                for (int j = 0; j < 8; ++j) ywn[j] = __builtin_nontemporal_load(yr + 64 * j); } }
        if (!xf) {
#pragma unroll
            for (int j = 0; j < 8; ++j) v[j] = (f32x4){bflo(xw[j].x), bfhi(xw[j].x), bflo(xw[j].y), bfhi(xw[j].y)}; }
        if (y) {
            f32x4 yv[8]; float s = 0.f;
#pragma unroll
            for (int j = 0; j < 8; ++j) { const u32x2 w = yw[j]; yv[j] = (f32x4){bflo(w.x), bfhi(w.x), bflo(w.y), bfhi(w.y)};
                s += (yv[j][0] * yv[j][0] + yv[j][1] * yv[j][1]) + (yv[j][2] * yv[j][2] + yv[j][3] * yv[j][3]); }
            s = wave_sum(s);
            const float rstd = 1.0f / sqrtf(s * (1.0f / DM) + NORM_EPS);
#pragma unroll
            for (int j = 0; j < 8; ++j) { const f32x4 gg = ((const f32x4*)gpost)[lane + 64 * j]; v[j] = v[j] + yv[j] * rstd * gg; }
            if (xof) { f32x4* xo = (f32x4*)(xof + (size_t)m * DM) + lane;
#pragma unroll
                for (int j = 0; j < 8; ++j) __builtin_nontemporal_store(v[j], xo + 64 * j); }
            else { u32x2* xo = (u32x2*)(xob + (size_t)m * DM) + lane;
#pragma unroll
                for (int j = 0; j < 8; ++j) { u32x2 w; w.x = cvt_pk_bf16(v[j][0], v[j][1]); w.y = cvt_pk_bf16(v[j][2], v[j][3]); __builtin_nontemporal_store(w, xo + 64 * j); } }
        }
        if (gnext) {
            float s = 0.f;
#pragma unroll
            for (int j = 0; j < 8; ++j) s += (v[j][0] * v[j][0] + v[j][1] * v[j][1]) + (v[j][2] * v[j][2] + v[j][3] * v[j][3]);
            s = wave_sum(s);
            const float rstd = 1.0f / sqrtf(s * (1.0f / DM) + NORM_EPS);
            u32x2* ho = (u32x2*)(hout + (size_t)m * DM) + lane;
#pragma unroll
            for (int j = 0; j < 8; ++j) { const f32x4 gg = ((const f32x4*)gnext)[lane + 64 * j]; const f32x4 o = v[j] * rstd * gg;
                u32x2 w; w.x = cvt_pk_bf16(o[0], o[1]); w.y = cvt_pk_bf16(o[2], o[3]); ho[64 * j] = w; }
        }
        if (!hn) break;
#pragma unroll
        for (int j = 0; j < 8; ++j) { v[j] = vn[j]; xw[j] = xwn[j]; yw[j] = ywn[j]; }
        m = mn;
    }
}

template <int R>
__device__ __forceinline__ void row_phase_b(const bf16_t* xb, const bf16_t* y, const float* gpost, bf16_t* xob, float* xof, const float* gnext, bf16_t* hout, int lane, int gw, int NGW) {
    if (gw >= T) return;
    const int nrows = (T - gw + NGW - 1) / NGW;
    u32x2 xw[R][8], yw[R][8];
#pragma unroll
    for (int i = 0; i < R; ++i) if (i < nrows) { const size_t m = (size_t)gw + (size_t)i * NGW;
        const u32x2* xr = (const u32x2*)(xb + m * DM) + lane; const u32x2* yr = (const u32x2*)(y + m * DM) + lane;
#pragma unroll
        for (int j = 0; j < 8; ++j) { xw[i][j] = __builtin_nontemporal_load(xr + 64 * j); yw[i][j] = __builtin_nontemporal_load(yr + 64 * j); } }
    for (int k0 = 0; k0 < nrows; k0 += R) {
#pragma unroll
        for (int i = 0; i < R; ++i) { const int k = k0 + i;
            if (k < nrows) {
                const size_t m = (size_t)gw + (size_t)k * NGW;
                f32x4 v[8], yv[8]; float s = 0.f;
#pragma unroll
                for (int j = 0; j < 8; ++j) { const u32x2 a = xw[i][j], w = yw[i][j];
                    v[j] = (f32x4){bflo(a.x), bfhi(a.x), bflo(a.y), bfhi(a.y)}; yv[j] = (f32x4){bflo(w.x), bfhi(w.x), bflo(w.y), bfhi(w.y)};
                    s += (yv[j][0] * yv[j][0] + yv[j][1] * yv[j][1]) + (yv[j][2] * yv[j][2] + yv[j][3] * yv[j][3]); }
                if (k + R < nrows) { const size_t mn = (size_t)gw + (size_t)(k + R) * NGW;
                    const u32x2* xr = (const u32x2*)(xb + mn * DM) + lane; const u32x2* yr = (const u32x2*)(y + mn * DM) + lane;
#pragma unroll
                    for (int j = 0; j < 8; ++j) { xw[i][j] = __builtin_nontemporal_load(xr + 64 * j); yw[i][j] = __builtin_nontemporal_load(yr + 64 * j); } }
                s = wave_sum(s);
                const float rstd = 1.0f / sqrtf(s * (1.0f / DM) + NORM_EPS);
#pragma unroll
                for (int j = 0; j < 8; ++j) { const f32x4 gg = ((const f32x4*)gpost)[lane + 64 * j]; v[j] = v[j] + yv[j] * rstd * gg; }
                if (xof) { f32x4* xo = (f32x4*)(xof + m * DM) + lane;
#pragma unroll
                    for (int j = 0; j < 8; ++j) __builtin_nontemporal_store(v[j], xo + 64 * j); }
                else { u32x2* xo = (u32x2*)(xob + m * DM) + lane;
#pragma unroll
                    for (int j = 0; j < 8; ++j) { u32x2 w; w.x = cvt_pk_bf16(v[j][0], v[j][1]); w.y = cvt_pk_bf16(v[j][2], v[j][3]); __builtin_nontemporal_store(w, xo + 64 * j); } }
                if (gnext) {
                    float s2 = 0.f;
#pragma unroll
                    for (int j = 0; j < 8; ++j) s2 += (v[j][0] * v[j][0] + v[j][1] * v[j][1]) + (v[j][2] * v[j][2] + v[j][3] * v[j][3]);
                    s2 = wave_sum(s2);
                    const float rstd2 = 1.0f / sqrtf(s2 * (1.0f / DM) + NORM_EPS);
                    u32x2* ho = (u32x2*)(hout + m * DM) + lane;
#pragma unroll
                    for (int j = 0; j < 8; ++j) { const f32x4 gg = ((const f32x4*)gnext)[lane + 64 * j]; const f32x4 o = v[j] * rstd2 * gg;
                        u32x2 w; w.x = cvt_pk_bf16(o[0], o[1]); w.y = cvt_pk_bf16(o[2], o[3]); ho[64 * j] = w; }
                }
            }
        }
    }
}

__device__ __forceinline__ void prep_phase(bf16_t* proj, const float* convw, bf16_t* qc, bf16_t* kc, int lane, int gw, int NGW) {
    if (gw >= T) return;
    constexpr int R = 4;
    const int nrows = (T - gw + NGW - 1) / NGW;
    const float invf = exp2f(-(float)lane * (13.287712379549449f / 64.0f));
    float cw[2][3][8];
#pragma unroll
    for (int jj = 0; jj < 2; ++jj)
#pragma unroll
        for (int tp = 0; tp < 3; ++tp) { const f32x4 w0 = *(const f32x4*)(convw + tp * 1024 + lane * 8 + 512 * jj), w1 = *(const f32x4*)(convw + tp * 1024 + lane * 8 + 512 * jj + 4);
            cw[jj][tp][0] = w0[0]; cw[jj][tp][1] = w0[1]; cw[jj][tp][2] = w0[2]; cw[jj][tp][3] = w0[3]; cw[jj][tp][4] = w1[0]; cw[jj][tp][5] = w1[1]; cw[jj][tp][6] = w1[2]; cw[jj][tp][7] = w1[3]; }
    u32x4 cur[R][2], prv[R][2], nxt[R][2]; bf16_t kx[R][4];
#define PREP_LOAD(slot, mrow) do { const size_t _m = (mrow); const int _pos = (int)(_m & (SEQ - 1)); const bf16_t* _pr = proj + _m * NPROJ; \
        _Pragma("unroll") for (int jj = 0; jj < 2; ++jj) { const int _ch = lane * 8 + 512 * jj; cur[slot][jj] = *(const u32x4*)(_pr + PC_MQ + _ch); \
            prv[slot][jj] = (u32x4){0u, 0u, 0u, 0u}; nxt[slot][jj] = (u32x4){0u, 0u, 0u, 0u}; \
            if (_pos > 0) prv[slot][jj] = *(const u32x4*)(_pr - NPROJ + PC_MQ + _ch); \
            if (_pos < SEQ - 1) nxt[slot][jj] = *(const u32x4*)(_pr + NPROJ + PC_MQ + _ch); } \
        kx[slot][0] = _pr[PC_AK + lane]; kx[slot][1] = _pr[PC_AK + 64 + lane]; kx[slot][2] = _pr[PC_AK + 128 + lane]; kx[slot][3] = _pr[PC_AK + 192 + lane]; } while (0)
#pragma unroll
    for (int i = 0; i < R; ++i) if (i < nrows) PREP_LOAD(i, (size_t)gw + (size_t)i * NGW);
    for (int k0 = 0; k0 < nrows; k0 += R) {
#pragma unroll
        for (int i = 0; i < R; ++i) { const int k = k0 + i;
            if (k < nrows) {
                const size_t m = (size_t)gw + (size_t)k * NGW;
                u32x4 c2[2], p2[2], n2[2]; bf16_t k4[4];
#pragma unroll
                for (int jj = 0; jj < 2; ++jj) { c2[jj] = cur[i][jj]; p2[jj] = prv[i][jj]; n2[jj] = nxt[i][jj]; }
#pragma unroll
                for (int q = 0; q < 4; ++q) k4[q] = kx[i][q];
                if (k + R < nrows) PREP_LOAD(i, (size_t)gw + (size_t)(k + R) * NGW);
                const int pos = (int)(m & (SEQ - 1));
                const float ang = (float)pos * invf;
                const double rev = (double)ang * 0.15915494309189535; const float f = (float)(rev - rint(rev));
                const float sn = __builtin_amdgcn_sinf(f), cs = __builtin_amdgcn_cosf(f);
                bf16_t* pr = proj + m * NPROJ;
#pragma unroll
                for (int hh = 0; hh < 2; ++hh) { const int base = PC_AK + hh * 128;
                    const float x1 = bf2f(k4[2 * hh]), x2 = bf2f(k4[2 * hh + 1]);
                    pr[base + lane] = f2bf(x1 * cs - x2 * sn); pr[base + 64 + lane] = f2bf(x2 * cs + x1 * sn); }
#pragma unroll
                for (int jj = 0; jj < 2; ++jj) { float yv[8];
#pragma unroll
                    for (int e = 0; e < 4; ++e) {
                        const float ya = cw[jj][0][2 * e] * bflo(p2[jj][e]) + cw[jj][1][2 * e] * bflo(c2[jj][e]) + cw[jj][2][2 * e] * bflo(n2[jj][e]);
                        const float yb = cw[jj][0][2 * e + 1] * bfhi(p2[jj][e]) + cw[jj][1][2 * e + 1] * bfhi(c2[jj][e]) + cw[jj][2][2 * e + 1] * bfhi(n2[jj][e]);
                        yv[2 * e] = ya * sigmoidf_(ya); yv[2 * e + 1] = yb * sigmoidf_(yb); }
                    if (jj == 0) {
#pragma unroll
                        for (int e = 0; e < 8; ++e) yv[e] *= 0.08838834764831845f; }
                    u32x4 o; o.x = cvt_pk_bf16(yv[0], yv[1]); o.y = cvt_pk_bf16(yv[2], yv[3]); o.z = cvt_pk_bf16(yv[4], yv[5]); o.w = cvt_pk_bf16(yv[6], yv[7]);
                    *(u32x4*)((jj == 0 ? qc : kc) + m * 512 + lane * 8) = o; }
            }
        }
    }
#undef PREP_LOAD
}

__device__ __forceinline__ void stage_nat128(const bf16_t* src, long ld, int nrows, int lo, int hi, LAS bf16_t* dst, int tid) {
    for (int idx = tid; idx < nrows * 16; idx += 512) { const int row = idx >> 4, c8 = idx & 15; u32x4 v = (u32x4){0u, 0u, 0u, 0u};
        if (row >= lo && row < hi) v = *(const u32x4*)(src + (long)row * ld + c8 * 8);
        *(LAS u32x4*)(dst + row * 136 + c8 * 8) = v; }
}
__device__ __forceinline__ void stage_T(const bf16_t* src, long ld, int nrows, int ncols, int lo, int hi, LAS bf16_t* dst, int VS, const LAS float* rowscale, int tid) {
    const int nrb = nrows >> 5, total = nrows * (ncols >> 3);
    for (int idx = tid; idx < total; idx += 512) {
        const int rlo = idx & 31, cl = (idx >> 5) & 1, rest = idx >> 6, rowblk = rest % nrb, cp = rest / nrb;
        const int row = rowblk * 32 + rlo, chunk = 2 * cp + cl;
        u32x4 v = (u32x4){0u, 0u, 0u, 0u};
        if (row >= lo && row < hi) v = *(const u32x4*)(src + (long)row * ld + chunk * 8);
        LAS bf16_t* d = dst + (chunk * 8) * VS + row;
        if (rowscale) { const float sc = rowscale[row];
#pragma unroll
            for (int e = 0; e < 4; ++e) { const unsigned w = cvt_pk_bf16(bflo(v[e]) * sc, bfhi(v[e]) * sc); d[(2 * e) * VS] = (bf16_t)(w & 0xffffu); d[(2 * e + 1) * VS] = (bf16_t)(w >> 16); }
        } else {
#pragma unroll
            for (int e = 0; e < 4; ++e) { d[(2 * e) * VS] = (bf16_t)(v[e] & 0xffffu); d[(2 * e + 1) * VS] = (bf16_t)(v[e] >> 16); }
        }
    }
}
__device__ __forceinline__ bf16x8 ld_pair(const LAS bf16_t* p0, const LAS bf16_t* p1) {
    const bf16x4 lo = *(const LAS bf16x4*)p0, hi = *(const LAS bf16x4*)p1;
    return __builtin_shufflevector(lo, hi, 0, 1, 2, 3, 4, 5, 6, 7);
}
__device__ __forceinline__ bf16x8 pack8(const f32x4 a, const f32x4 b) {
    u32x4 w; w.x = cvt_pk_bf16(a[0], a[1]); w.y = cvt_pk_bf16(a[2], a[3]); w.z = cvt_pk_bf16(b[0], b[1]); w.w = cvt_pk_bf16(b[2], b[3]);
    return (bf16x8)w;
}

template <int N> __device__ __forceinline__ void ld_nat(const bf16_t* src, long ld, int lo, int hi, int tid, u32x4 (&v)[N]) {
#pragma unroll
    for (int i = 0; i < N; ++i) { const int idx = tid + 512 * i, row = idx >> 4, c8 = idx & 15; v[i] = (u32x4){0u, 0u, 0u, 0u};
        if (row >= lo && row < hi) v[i] = *(const u32x4*)(src + (long)row * ld + c8 * 8); }
}
template <int N> __device__ __forceinline__ void st_nat(const u32x4 (&v)[N], LAS bf16_t* dst, int tid) {
    asm volatile("" : "+v"(tid));
#pragma unroll
    for (int i = 0; i < N; ++i) { const int idx = tid + 512 * i, row = idx >> 4, c8 = idx & 15; *(LAS u32x4*)(dst + row * 136 + c8 * 8) = v[i]; }
}
template <int N, int NROWS> __device__ __forceinline__ void ld_T(const bf16_t* src, long ld, int lo, int hi, int tid, u32x4 (&v)[N]) {
    constexpr int nrb = NROWS >> 5;
#pragma unroll
    for (int i = 0; i < N; ++i) { const int idx = tid + 512 * i, rlo = idx & 31, cl = (idx >> 5) & 1, rest = idx >> 6, rowblk = rest % nrb, cp = rest / nrb;
        const int row = rowblk * 32 + rlo, chunk = 2 * cp + cl; v[i] = (u32x4){0u, 0u, 0u, 0u};
        if (row >= lo && row < hi) v[i] = *(const u32x4*)(src + (long)row * ld + chunk * 8); }
}
template <int N, int NROWS> __device__ __forceinline__ void st_T(const u32x4 (&v)[N], LAS bf16_t* dst, int VS, const LAS float* rowscale, int tid) {
    constexpr int nrb = NROWS >> 5;
    asm volatile("" : "+v"(tid));
#pragma unroll
    for (int i = 0; i < N; ++i) { const int idx = tid + 512 * i, rlo = idx & 31, cl = (idx >> 5) & 1, rest = idx >> 6, rowblk = rest % nrb, cp = rest / nrb;
        const int row = rowblk * 32 + rlo, chunk = 2 * cp + cl;
        LAS bf16_t* d = dst + (chunk * 8) * VS + row;
        if (rowscale) { const float sc = rowscale[row];
#pragma unroll
            for (int e = 0; e < 4; ++e) { const unsigned w = cvt_pk_bf16(bflo(v[i][e]) * sc, bfhi(v[i][e]) * sc); d[(2 * e) * VS] = (bf16_t)(w & 0xffffu); d[(2 * e + 1) * VS] = (bf16_t)(w >> 16); }
        } else {
#pragma unroll
            for (int e = 0; e < 4; ++e) { d[(2 * e) * VS] = (bf16_t)(v[i][e] & 0xffffu); d[(2 * e + 1) * VS] = (bf16_t)(v[i][e] >> 16); }
        } }
}

__device__ __forceinline__ void attn_item(int item, bf16_t* proj, const float* sink, LAS unsigned char* lds, int tid) {
    const int j = item & 63, qh = (item >> 6) & 7, b = item >> 9, kvh = qh >> 2;
    const int wave = tid >> 6, lane = tid & 63, r = lane & 15, fq = lane >> 4;
    LAS bf16_t* Ks = (LAS bf16_t*)lds;
    LAS bf16_t* Vt = (LAS bf16_t*)lds;
    const int kpos0 = j * 128 - 128;
    const int lo = kpos0 < 0 ? -kpos0 : 0, hi = (kpos0 + 384 > SEQ) ? SEQ - kpos0 : 384;
    const bf16_t* kbase = proj + ((long)b * SEQ + kpos0) * NPROJ + PC_AK + kvh * 128;
    const bf16_t* vbase = proj + ((long)b * SEQ + kpos0) * NPROJ + PC_AV + kvh * 128;
    __syncthreads();
    stage_nat128(kbase, NPROJ, 384, lo, hi, Ks, tid);
    bf16_t* qrow = proj + ((size_t)b * SEQ + j * 128 + wave * 16 + r) * NPROJ + PC_AQ + qh * 128;
    bf16x8 qf[4];
#pragma unroll
    for (int ks = 0; ks < 4; ++ks) qf[ks] = *(const bf16x8*)(qrow + ks * 32 + fq * 8);
    {
        const float posf = (float)(j * 128 + wave * 16 + r);
#pragma unroll
        for (int k2 = 0; k2 < 2; ++k2) { const u32x4 xa = (u32x4)qf[k2], xb = (u32x4)qf[k2 + 2]; float y1[8], y2[8];
#pragma unroll
            for (int e = 0; e < 8; ++e) { const float invf = exp2f(-(float)(k2 * 32 + fq * 8 + e) * (13.287712379549449f / 64.0f));
                const float ang = posf * invf; const double rev = (double)ang * 0.15915494309189535; const float fr = (float)(rev - rint(rev));
                const float sn = __builtin_amdgcn_sinf(fr), cs = __builtin_amdgcn_cosf(fr);
                const float x1 = (e & 1) ? bfhi(xa[e >> 1]) : bflo(xa[e >> 1]), x2 = (e & 1) ? bfhi(xb[e >> 1]) : bflo(xb[e >> 1]);
                y1[e] = x1 * cs - x2 * sn; y2[e] = x2 * cs + x1 * sn; }
            u32x4 oa, ob;
#pragma unroll
            for (int e = 0; e < 4; ++e) { oa[e] = cvt_pk_bf16(y1[2 * e], y1[2 * e + 1]); ob[e] = cvt_pk_bf16(y2[2 * e], y2[2 * e + 1]); }
            qf[k2] = (bf16x8)oa; qf[k2 + 2] = (bf16x8)ob; } }
    __syncthreads();
    const int w = __builtin_amdgcn_readfirstlane(wave);
    const bool jf = (j != 0), jl = (j != 63);
#define ATT_TV(st) ((st) < 8 ? ((st) >= w && jf) : ((st) < 16 ? true : (((st) - 16) <= w && jl)))
    f32x4 sacc[24];
#pragma unroll
    for (int st = 0; st < 24; ++st) { f32x4 a4 = (f32x4){0.f, 0.f, 0.f, 0.f};
        if (ATT_TV(st)) {
#pragma unroll
            for (int ks = 0; ks < 4; ++ks) { const bf16x8 a = *(const LAS bf16x8*)(Ks + (16 * st + r) * 136 + ks * 32 + fq * 8); a4 = MFMA16(a, qf[ks], a4); } }
        sacc[st] = a4; }
    const float cs2 = 0.08838834764831845f * 1.4426950408889634f;
    const float snk2 = sink[qh] * 1.4426950408889634f;
    float mx = -3.0e38f;
#pragma unroll
    for (int st = 0; st < 24; ++st) {
        if (ATT_TV(st)) {
#pragma unroll
            for (int jj = 0; jj < 4; ++jj) { float sv = sacc[st][jj];
                if (st < 8) { if (st == w) sv = (4 * fq + jj >= r) ? sv : -3.0e38f; }
                else if (st >= 16) { if (st - 16 == w) sv = (4 * fq + jj <= r) ? sv : -3.0e38f; }
                sacc[st][jj] = sv; mx = fmaxf(mx, sv); } } }
    mx = fmaxf(mx, __shfl_xor(mx, 16)); mx = fmaxf(mx, __shfl_xor(mx, 32));
    const float m2 = fmaxf(mx * cs2, snk2);
    float sum = 0.f;
#pragma unroll
    for (int st = 0; st < 24; ++st) {
        if (ATT_TV(st)) {
#pragma unroll
            for (int jj = 0; jj < 4; ++jj) { const float p = __builtin_amdgcn_exp2f(fmaf(sacc[st][jj], cs2, -m2)); sacc[st][jj] = p; sum += p; } }
        else sacc[st] = (f32x4){0.f, 0.f, 0.f, 0.f}; }
    sum += __shfl_xor(sum, 16); sum += __shfl_xor(sum, 32);
    const float inv = 1.0f / (sum + __builtin_amdgcn_exp2f(snk2 - m2));
    bf16x8 pb[12];
#pragma unroll
    for (int kp = 0; kp < 12; ++kp) pb[kp] = pack8(sacc[2 * kp], sacc[2 * kp + 1]);
    __syncthreads();
    stage_T(vbase, NPROJ, 384, 128, lo, hi, Vt, 396, nullptr, tid);
    __syncthreads();
    f32x4 o[8];
#pragma unroll
    for (int dt = 0; dt < 8; ++dt) o[dt] = (f32x4){0.f, 0.f, 0.f, 0.f};
#pragma unroll
    for (int kp = 0; kp < 12; ++kp) {
        if (ATT_TV(2 * kp) || ATT_TV(2 * kp + 1)) {
            const LAS bf16_t* vr = Vt + r * 396 + 4 * fq + kp * 32;
#pragma unroll
            for (int dt = 0; dt < 8; ++dt) { const bf16x8 a = ld_pair(vr + dt * (16 * 396), vr + dt * (16 * 396) + 16); o[dt] = MFMA16(a, pb[kp], o[dt]); } } }
#pragma unroll
    for (int dt = 0; dt < 8; ++dt) { u32x2 wv; wv.x = cvt_pk_bf16(o[dt][0] * inv, o[dt][1] * inv); wv.y = cvt_pk_bf16(o[dt][2] * inv, o[dt][3] * inv);
        *(u32x2*)(qrow + 16 * dt + 4 * fq) = wv; }
#undef ATT_TV
}

__device__ __forceinline__ void mlstm_local_item(int item, const bf16_t* proj, const bf16_t* kc, const float* gates, const float* gbias, bf16_t* Cb, float* nb, float* mloc, float* gch,
                                                 LAS unsigned char* lds, int tid) {
    asm volatile("" : "+v"(tid));
    const int c = item & 63, h = (item >> 6) & 3, b = item >> 8;
    const int wave = tid >> 6, lane = tid & 63, r = lane & 15, fq = lane >> 4;
    const long row0 = (long)b * SEQ + c * 128;
    const int bh = b * 4 + h;
    LAS bf16_t* Kt = (LAS bf16_t*)lds;
    LAS bf16_t* Vt = (LAS bf16_t*)(lds + 33792);
    LAS float* lf = (LAS float*)(lds + 101376);
    LAS float* li = lf + 256; LAS float* aa = lf + 512; LAS float* we = lf + 768;
    u32x4 vreg[8], kreg[4]; float gi = 0.f, gf = 0.f;
    ld_T<8, 128>(proj + row0 * NPROJ + PC_MV + h * 256, NPROJ, 0, 128, tid, vreg);
    ld_T<4, 128>(kc + row0 * 512 + h * 128, 512, 0, 128, tid, kreg);
    if (tid < 256) { const int dir = tid >> 7, l = tid & 127;
        gi = gates[(row0 + l) * 16 + (2 * dir) * 4 + h] + gbias[(2 * dir) * 4 + h];
        gf = gates[(row0 + l) * 16 + (2 * dir + 1) * 4 + h] + gbias[(2 * dir + 1) * 4 + h]; }
    __syncthreads();
    if (tid < 256) { li[tid] = gi; lf[tid] = logsigmoid_(gf); }
    st_T<8, 128>(vreg, Vt, 132, nullptr, tid);
    __syncthreads();
    if (tid < 256) { const int dir = tid >> 7, l = tid & 127; float acc = 0.f, tot = 0.f;
        for (int q = 0; q < 128; ++q) { const float v = lf[dir * 128 + q]; tot += v; acc += (q <= l) ? v : 0.f; }
        if (dir) acc = tot - acc + lf[dir * 128 + l];
        aa[tid] = tot - acc + li[tid];
        if (l == 0) gch[(bh * 2 + dir) * 64 + c] = tot; }
    __syncthreads();
    if (tid < 256) { const int dir = tid >> 7, l = tid & 127; float mxx = -3.0e38f;
        for (int q = 0; q < 128; ++q) mxx = fmaxf(mxx, aa[dir * 128 + q]);
        we[tid] = expf(aa[tid] - mxx);
        if (l == 0) mloc[(bh * 2 + dir) * 64 + c] = mxx; }
    bf16x8 bfr[2][4];
#pragma unroll
    for (int dd = 0; dd < 2; ++dd)
#pragma unroll
        for (int ks = 0; ks < 4; ++ks) { const LAS bf16_t* p = Vt + ((2 * wave + dd) * 16 + r) * 132 + ks * 32 + fq * 8; bfr[dd][ks] = ld_pair(p, p + 4); }
#pragma unroll 1
    for (int dir = 0; dir < 2; ++dir) {
        const int si = (bh * 2 + dir) * 64 + c;
        __syncthreads();
        st_T<4, 128>(kreg, Kt, 132, we + dir * 128, tid);
        __syncthreads();
        if (tid < 128) { float sn = 0.f; const LAS bf16_t* kr = Kt + tid * 132;
            for (int q = 0; q < 128; q += 4) { const u32x2 wv = *(const LAS u32x2*)(kr + q); sn += (bflo(wv.x) + bfhi(wv.x)) + (bflo(wv.y) + bfhi(wv.y)); }
            nb[(size_t)si * 128 + tid] = sn; }
        bf16_t* Cg = Cb + (size_t)si * 256 * 128;
#pragma unroll
        for (int dkt = 0; dkt < 8; ++dkt) { f32x4 a0 = (f32x4){0.f, 0.f, 0.f, 0.f}, a1 = (f32x4){0.f, 0.f, 0.f, 0.f};
#pragma unroll
            for (int ks = 0; ks < 4; ++ks) { const LAS bf16_t* p = Kt + (dkt * 16 + r) * 132 + ks * 32 + fq * 8; const bf16x8 a = ld_pair(p, p + 4);
                a0 = MFMA16(a, bfr[0][ks], a0); a1 = MFMA16(a, bfr[1][ks], a1); }
            u32x2 w0; w0.x = cvt_pk_bf16(a0[0], a0[1]); w0.y = cvt_pk_bf16(a0[2], a0[3]);
            u32x2 w1; w1.x = cvt_pk_bf16(a1[0], a1[1]); w1.y = cvt_pk_bf16(a1[2], a1[3]);
            *(u32x2*)(Cg + (size_t)((2 * wave) * 16 + r) * 128 + dkt * 16 + 4 * fq) = w0;
            *(u32x2*)(Cg + (size_t)((2 * wave + 1) * 16 + r) * 128 + dkt * 16 + 4 * fq) = w1; }
    }
}

__device__ __forceinline__ void mlstm_scan(bf16_t* Cb, float* nb, const float* mloc, const float* gch, float* mprev, int tid) {
    for (int vb = blockIdx.x; vb < 256; vb += gridDim.x) {
        const int bhd = vb >> 4, part = vb & 15, dir = bhd & 1;
        bf16_t* Cp = Cb + (size_t)bhd * 64 * 32768 + (size_t)(part * 512 + tid) * 4;
        const bool do_n = (part == 0) && (tid < 128);
        float* np = nb + (size_t)bhd * 64 * 128 + (tid & 127);
        float c0 = 0.f, c1 = 0.f, c2 = 0.f, c3 = 0.f, cn = 0.f, m = -1.0e30f;
        for (int s0 = 0; s0 < 64; s0 += 8) {
            u32x2 v[8]; float gg[8], ml[8], nv[8];
#pragma unroll
            for (int q = 0; q < 8; ++q) { const int c = dir ? 63 - (s0 + q) : (s0 + q);
                v[q] = *(const u32x2*)(Cp + (size_t)c * 32768); gg[q] = gch[bhd * 64 + c]; ml[q] = mloc[bhd * 64 + c]; nv[q] = do_n ? np[c * 128] : 0.f; }
#pragma unroll
            for (int q = 0; q < 8; ++q) { const int c = dir ? 63 - (s0 + q) : (s0 + q);
                u32x2 o; o.x = cvt_pk_bf16(c0, c1); o.y = cvt_pk_bf16(c2, c3);
                *(u32x2*)(Cp + (size_t)c * 32768) = o;
                if (do_n) np[c * 128] = cn;
                if (part == 0 && tid == 0) mprev[bhd * 64 + c] = m;
                const float mn = fmaxf(gg[q] + m, ml[q]);
                const float sp = expf(gg[q] + m - mn), sl = expf(ml[q] - mn);
                c0 = sp * c0 + sl * bflo(v[q].x); c1 = sp * c1 + sl * bfhi(v[q].x); c2 = sp * c2 + sl * bflo(v[q].y); c3 = sp * c3 + sl * bfhi(v[q].y);
                cn = sp * cn + sl * nv[q];
                m = mn; }
        }
    }
}

__device__ __forceinline__ void mlstm_out_item(int item, bf16_t* proj, const bf16_t* qc, const bf16_t* kc, const float* gates, const float* gbias, const bf16_t* Cb, const float* nb,
                                               const float* mprev, const float* gnorm, LAS unsigned char* lds, int tid) {
    asm volatile("" : "+v"(tid));
    const int c = item & 63, h = (item >> 6) & 3, b = item >> 8;
    const int wave = tid >> 6, lane = tid & 63, r = lane & 15, fq = lane >> 4;
    const long row0 = (long)b * SEQ + c * 128;
    const int bh = b * 4 + h;
    LAS bf16_t* Ks = (LAS bf16_t*)lds;
    LAS bf16_t* Vt = (LAS bf16_t*)(lds + 34816);
    LAS float* fl = (LAS float*)(lds + 104448);
    LAS float* lf = fl; LAS float* li = fl + 256; LAS float* bb = fl + 512; LAS float* ee = fl + 768; LAS float* Mt = fl + 1024; LAS float* mpl = fl + 1280; LAS float* npv = fl + 1536;
    const int t = 16 * wave + r;
    float mpv = 0.f;
    { u32x4 kreg[4], vreg[8]; float gi = 0.f, gf = 0.f, nn = 0.f;
      ld_nat<4>(kc + row0 * 512 + h * 128, 512, 0, 128, tid, kreg);
      ld_T<8, 128>(proj + row0 * NPROJ + PC_MV + h * 256, NPROJ, 0, 128, tid, vreg);
      if (tid < 256) { const int dir = tid >> 7, l = tid & 127; const int si = (bh * 2 + dir) * 64 + c;
          gi = gates[(row0 + l) * 16 + (2 * dir) * 4 + h] + gbias[(2 * dir) * 4 + h];
          gf = gates[(row0 + l) * 16 + (2 * dir + 1) * 4 + h] + gbias[(2 * dir + 1) * 4 + h];
          nn = nb[(size_t)si * 128 + l]; mpv = mprev[si]; }
      __syncthreads();
      if (tid < 256) { li[tid] = gi; lf[tid] = logsigmoid_(gf); npv[tid] = nn; }
      st_nat<4>(kreg, Ks, tid);
      st_T<8, 128>(vreg, Vt, 136, nullptr, tid); }
    __syncthreads();
    if (tid < 256) { const int dir = tid >> 7, l = tid & 127; float acc = 0.f, tot = 0.f;
        for (int q = 0; q < 128; ++q) { const float v = lf[dir * 128 + q]; tot += v; acc += (q <= l) ? v : 0.f; }
        if (dir) acc = tot - acc + lf[dir * 128 + l];
        bb[tid] = acc; ee[tid] = li[tid] - acc; }
    __syncthreads();
    if (tid < 256) { const int dir = tid >> 7, l = tid & 127; float pmf = -3.0e38f, pmb = -3.0e38f;
        for (int q = 0; q < 128; ++q) { const float v = ee[dir * 128 + q]; pmf = fmaxf(pmf, (q <= l) ? v : -3.0e38f); pmb = fmaxf(pmb, (q >= l) ? v : -3.0e38f); }
        Mt[tid] = fmaxf(mpv, dir ? pmb : pmf);
        if (l == 0) mpl[dir] = mpv; }
    __syncthreads();
    bf16x8 qf[4];
    { const bf16_t* qr = qc + (row0 + t) * 512 + h * 128;
#pragma unroll
      for (int ks = 0; ks < 4; ++ks) qf[ks] = *(const bf16x8*)(qr + ks * 32 + fq * 8); }
    f32x4 sacc[8];
#pragma unroll
    for (int st = 0; st < 8; ++st) { f32x4 a4 = (f32x4){0.f, 0.f, 0.f, 0.f};
#pragma unroll
        for (int ks = 0; ks < 4; ++ks) { const bf16x8 a = *(const LAS bf16x8*)(Ks + (16 * st + r) * 136 + ks * 32 + fq * 8); a4 = MFMA16(a, qf[ks], a4); }
        sacc[st] = a4; }
    __syncthreads();
    LAS bf16_t* hsl = (LAS bf16_t*)(wave < 4 ? lds + wave * 8320 : lds + 111616 + (wave - 4) * 8320) + r * 260 + 4 * fq;
    bf16x8 pb[2][4]; float inv[2], wi[2];
    const int w = __builtin_amdgcn_readfirstlane(wave);
    const float L2E = 1.4426950408889634f;
#pragma unroll
    for (int dir = 0; dir < 2; ++dir) {
        const float Mv = Mt[dir * 128 + t]; const float mp = mpl[dir];
        const float winter = __builtin_amdgcn_exp2f((mp - Mv) * L2E);
        float qd = 0.f;
#pragma unroll
        for (int ks = 0; ks < 4; ++ks) { const LAS float* np = npv + dir * 128 + ks * 32 + fq * 8; const u32x4 qw = (u32x4)qf[ks];
            qd += bflo(qw.x) * np[0] + bfhi(qw.x) * np[1] + bflo(qw.y) * np[2] + bfhi(qw.y) * np[3] + bflo(qw.z) * np[4] + bfhi(qw.z) * np[5] + bflo(qw.w) * np[6] + bfhi(qw.w) * np[7]; }
        qd += __shfl_xor(qd, 16); qd += __shfl_xor(qd, 32);
        float den = 0.f; f32x4 pv[8];
#pragma unroll
        for (int st = 0; st < 8; ++st)
#pragma unroll
            for (int jj = 0; jj < 4; ++jj) { const int sidx = 16 * st + 4 * fq + jj; const bool valid = dir ? (sidx >= t) : (sidx <= t);
                const float wgt = valid ? __builtin_amdgcn_exp2f((ee[dir * 128 + sidx] - Mv) * L2E) : 0.f; const float p = sacc[st][jj] * wgt; den += p; pv[st][jj] = p; }
#pragma unroll
        for (int kp = 0; kp < 4; ++kp) pb[dir][kp] = pack8(pv[2 * kp], pv[2 * kp + 1]);
        den += __shfl_xor(den, 16); den += __shfl_xor(den, 32);
        const float dent = den + winter * qd;
        const float denom = fmaxf(fabsf(dent), expf(-(bb[dir * 128 + t] + Mv)));
        inv[dir] = 1.0f / denom; wi[dir] = winter;
    }
    float ss = 0.f;
    bf16_t* orow = proj + (size_t)(row0 + t) * NPROJ + PC_MO + h * 256;
    LAS bf16_t* SL = (LAS bf16_t*)(lds + 144896);
    const int srow = (tid >> 4) & 31, sc8 = tid & 15;
    const bf16_t* sg0 = Cb + (size_t)((bh * 2 + 0) * 64 + c) * 32768 + srow * 128 + sc8 * 8;
    const bf16_t* sg1 = Cb + (size_t)((bh * 2 + 1) * 64 + c) * 32768 + srow * 128 + sc8 * 8;
    LAS bf16_t* sdst = SL + srow * 136 + sc8 * 8;
    u32x4 pre0 = *(const u32x4*)sg0, pre1 = *(const u32x4*)sg1;
#pragma unroll 1
    for (int sl = 0; sl < 8; ++sl) {
        __syncthreads();
        *(LAS u32x4*)sdst = pre0; *(LAS u32x4*)(sdst + 32 * 136) = pre1;
        __syncthreads();
        { const int sn = sl < 7 ? sl + 1 : 7; pre0 = *(const u32x4*)(sg0 + (size_t)sn * 4096); pre1 = *(const u32x4*)(sg1 + (size_t)sn * 4096); }
#pragma unroll
        for (int d2 = 0; d2 < 2; ++d2) {
            const int dvt = sl * 2 + d2;
            f32x4 hsum = (f32x4){0.f, 0.f, 0.f, 0.f};
            const LAS bf16_t* vr = Vt + (dvt * 16 + r) * 136 + 4 * fq;
#pragma unroll
            for (int dir = 0; dir < 2; ++dir) {
                f32x4 a4 = (f32x4){0.f, 0.f, 0.f, 0.f};
                const LAS bf16_t* cr = SL + dir * (32 * 136) + (d2 * 16 + r) * 136 + fq * 8;
#pragma unroll
                for (int ks = 0; ks < 4; ++ks) { const bf16x8 a = *(const LAS bf16x8*)(cr + ks * 32); a4 = MFMA16(a, qf[ks], a4); }
                a4 = a4 * wi[dir];
#pragma unroll
                for (int kp = 0; kp < 4; ++kp) { const bf16x8 a = ld_pair(vr + kp * 32, vr + kp * 32 + 16); a4 = MFMA16(a, pb[dir][kp], a4); }
                hsum = hsum + a4 * inv[dir];
            }
            ss += (hsum[0] * hsum[0] + hsum[1] * hsum[1]) + (hsum[2] * hsum[2] + hsum[3] * hsum[3]);
            u32x2 w; w.x = cvt_pk_bf16(hsum[0], hsum[1]); w.y = cvt_pk_bf16(hsum[2], hsum[3]);
            *(LAS u32x2*)(hsl + dvt * 16) = w;
        }
    }
    ss += __shfl_xor(ss, 16); ss += __shfl_xor(ss, 32);
    const float rn = 1.0f / sqrtf(ss * (1.0f / 256.0f) + NORM_EPS);
#pragma unroll 8
    for (int dvt = 0; dvt < 16; ++dvt) { const int dv0 = dvt * 16 + 4 * fq;
        const f32x4 gg = *(const f32x4*)(gnorm + h * 256 + dv0);
        const u32x2 mo = *(const u32x2*)(orow + dv0);
        const u32x2 v = *(const LAS u32x2*)(hsl + dvt * 16);
        const float o0 = bflo(v.x) * rn * gg[0] * sigmoidf_(bflo(mo.x)), o1 = bfhi(v.x) * rn * gg[1] * sigmoidf_(bfhi(mo.x));
        const float o2 = bflo(v.y) * rn * gg[2] * sigmoidf_(bflo(mo.y)), o3 = bfhi(v.y) * rn * gg[3] * sigmoidf_(bfhi(mo.y));
        u32x2 w; w.x = cvt_pk_bf16(o0, o1); w.y = cvt_pk_bf16(o2, o3);
        *(u32x2*)(orow + dv0) = w; }
}


#define XB_TMO      128
#define XB_XCNT(j)  (256  + 64 * (j))
#define XB_XSUB(j)  (1280 + 64 * (j))
#define XB_XGEN(j)  (2304 + 64 * (j))
#define XB_TOP      3328
#define XB_TOPGEN   3392
#define XCD_BAR_WORDS 3456
#define XB_SPIN_CAP (1u << 20)
__device__ __forceinline__ unsigned xb_ld(unsigned* p)              { return __hip_atomic_load(p, __ATOMIC_RELAXED, __HIP_MEMORY_SCOPE_AGENT); }
__device__ __forceinline__ unsigned xb_add(unsigned* p, unsigned v) { return __hip_atomic_fetch_add(p, v, __ATOMIC_RELAXED, __HIP_MEMORY_SCOPE_AGENT); }
__device__ __forceinline__ unsigned xb_xcc_id() { return (unsigned)__builtin_amdgcn_s_getreg((3 << 11) | 20) & 0xFu; }
#define XB_SPIN(cond, bar) do { unsigned _sp = 0; while (cond) { __builtin_amdgcn_s_sleep(1); \
    if ((++_sp & 255u) == 0u) { if (xb_ld(&(bar)[XB_TMO])) break; if (_sp > XB_SPIN_CAP) { atomicAdd(&(bar)[XB_TMO], 1u); break; } } } } while (0)
struct XcdBarrier { unsigned* bar; unsigned x; volatile LAS unsigned* st; };
__device__ __forceinline__ XcdBarrier xcd_barrier_post(unsigned* bar, volatile LAS unsigned* st) {
    XcdBarrier b; b.bar = bar; b.x = xb_xcc_id(); b.st = st;
    if (threadIdx.x == 0) (void)xb_add(&bar[XB_XCNT(b.x)], 1u);
    return b;
}
__device__ __forceinline__ void xcd_barrier_complete(unsigned* bar, unsigned x, unsigned& nloc, unsigned& nx) {
    const unsigned G = gridDim.x * gridDim.y * gridDim.z;
    unsigned sum, cnt, mine, sp = 0u;
    for (;;) {
        sum = 0u; cnt = 0u; mine = 0u;
#pragma unroll
        for (unsigned j = 0; j < 16; ++j) { const unsigned c = xb_ld(&bar[XB_XCNT(j)]); sum += c; cnt += (c > 0u) ? 1u : 0u; mine = (j == x) ? c : mine; }
        if (sum == G) break;
        __builtin_amdgcn_s_sleep(1);
        if ((++sp & 255u) == 0u) { if (xb_ld(&bar[XB_TMO])) break; if (sp > XB_SPIN_CAP) { atomicAdd(&bar[XB_TMO], 1u); break; } }
    }
    nloc = mine > 0u ? mine : 1u; nx = cnt > 0u ? cnt : 1u;
}
__device__ __forceinline__ void xcd_barrier(const XcdBarrier& b) {
    asm volatile("s_waitcnt vmcnt(0)" ::: "memory");
    __syncthreads();
    if (threadIdx.x == 0) {
        unsigned* bar = b.bar;
        __builtin_amdgcn_s_waitcnt(0);
        unsigned nloc = b.st[0], nx = b.st[1];
        if (nloc == 0u) { xcd_barrier_complete(bar, b.x, nloc, nx); b.st[0] = nloc; b.st[1] = nx; }
        const unsigned old = xb_add(&bar[XB_XSUB(b.x)], 1u);
        const unsigned gen = old / nloc;
        if (old + 1u == (gen + 1u) * nloc) {
            __builtin_amdgcn_fence(__ATOMIC_RELEASE, "agent");
            asm volatile("s_waitcnt vmcnt(0)" ::: "memory");
            const unsigned og = xb_add(&bar[XB_TOP], 1u);
            const unsigned tg = og / nx;
            if (og + 1u == (tg + 1u) * nx) xb_add(&bar[XB_TOPGEN], 1u);
            else XB_SPIN(xb_ld(&bar[XB_TOPGEN]) == tg, bar);
            __builtin_amdgcn_fence(__ATOMIC_ACQUIRE, "agent");
            xb_add(&bar[XB_XGEN(b.x)], 1u);
            asm volatile("s_waitcnt vmcnt(0)" ::: "memory");
        } else {
            XB_SPIN(xb_ld(&bar[XB_XGEN(b.x)]) == gen, bar);
            __builtin_amdgcn_fence(__ATOMIC_ACQUIRE, "agent");
            asm volatile("s_waitcnt vmcnt(0)" ::: "memory");
        }
    }
    __syncthreads();
}

struct Args {
    const float* x; const float* w_in; const float* conv_w; const float* gate_bias; const float* ml_norm_g; const float* attn_sink; const float* w_out;
    const float* g_pre_mix; const float* g_post_mix; const float* g_pre_mlp; const float* g_post_mlp; const float* w_up; const float* w_down;
    float* out; unsigned char* ws; int ph_lo, ph_hi;
};

__global__ void __launch_bounds__(512, 2) mega(Args a) {
    extern __shared__ __attribute__((aligned(16))) unsigned char lds_raw[];
    LAS unsigned char* lds = (LAS unsigned char*)lds_raw;
    cg::grid_group grid = cg::this_grid();
    unsigned char* ws = a.ws;
    bf16_t* proj = (bf16_t*)(ws + WS_PROJ); bf16_t* qc = (bf16_t*)(ws + WS_QC); bf16_t* kc = (bf16_t*)(ws + WS_KC); bf16_t* Cb = (bf16_t*)(ws + WS_CB);
    float* gates = (float*)(ws + WS_GATES); float* nb = (float*)(ws + WS_NB); float* mloc = (float*)(ws + WS_ML); float* gch = (float*)(ws + WS_GC); float* mprev = (float*)(ws + WS_MP);
    bf16_t* ubuf = (bf16_t*)(ws + WS_U); bf16_t* mixA = (bf16_t*)(ws + WS_MIXO); bf16_t* mixB = (bf16_t*)(ws + WS_HB);
    bf16_t* hb = (bf16_t*)a.out;
    bf16_t* W0 = (bf16_t*)(ws + WS_W0); bf16_t* W1 = (bf16_t*)(ws + WS_W1); bf16_t* W2 = (bf16_t*)(ws + WS_W2);

    volatile LAS unsigned* xb_st = (volatile LAS unsigned*)(lds + LDS_BYTES - 16);
    if (threadIdx.x < 4) xb_st[threadIdx.x] = 0u;
    __syncthreads();
    XcdBarrier xbar = xcd_barrier_post((unsigned*)(ws + WS_BAR), xb_st);
    for (int ph = a.ph_lo; ph < a.ph_hi; ++ph) {
        int tid = threadIdx.x; asm volatile("" : "+v"(tid));
        const int lane = tid & 63, wave = __builtin_amdgcn_readfirstlane(tid >> 6);
        const int gw = blockIdx.x * 8 + wave, NGW = gridDim.x * 8;
        LAS float* scr = (LAS float*)(lds + wave * 16640);
        const int l = (ph == 0) ? 0 : (ph - 1) / 10, pt = (ph == 0) ? -1 : (ph - 1) % 10;
        if (ph == 0 && (PHMASK & 1)) {
            convert_win(a.w_in, W0, scr, lane, gw, NGW);
            convert_plain(a.w_out, DM, DM, W2, scr, lane, gw, NGW);
            row_phase(a.x, nullptr, nullptr, nullptr, nullptr, nullptr, a.g_pre_mix, hb, lane, gw, NGW);
        } else if ((PHMASK & 2) && (pt == 0 || pt == 5 || pt == 7 || pt == 8)) {
            pg8::Gemm g; pg8::Epi E; E.gates = gates; E.gate_pn = -1; E.act = 0;
            if (pt == 0)      { g = pg8::Gemm{hb, W0, T, NIN, DM, DM};      E.O = proj; E.ldc = NPROJ; E.gate_pn = 18; }
            else if (pt == 5) { g = pg8::Gemm{proj, W2, T, DM, DM, NPROJ};  E.O = mixA; E.ldc = DM; }
            else if (pt == 7) { g = pg8::Gemm{hb, W0, T, FF, DM, DM};       E.O = ubuf; E.ldc = FF; E.act = 1; }
            else              { g = pg8::Gemm{ubuf, W1, T, DM, FF, FF};     E.O = mixB; E.ldc = DM; }
            pg8::StaticOrder S; S.init(g.M, g.N, (int)gridDim.x, (int)blockIdx.x);
            pg8::gemm_phase(lds, g, S, E, tid);
            if (pt == 0) {
                const int rem = (T / 256) * (NIN / 256) % (int)gridDim.x;
                if (rem != 0 && (int)blockIdx.x >= rem) { __syncthreads();
                    convert_plain(a.w_down + (size_t)l * FF * DM, FF, DM, W1, scr, lane, ((int)blockIdx.x - rem) * 8 + wave, ((int)gridDim.x - rem) * 8); }
            }
        } else if ((PHMASK & 4) && pt == 1) {
            prep_phase(proj, a.conv_w + (size_t)l * 3 * 1024, qc, kc, lane, gw, NGW);
        } else if ((PHMASK & 8) && pt == 2) {
            for (int it = blockIdx.x; it < 1536; it += gridDim.x) {
                if (it < 1024) { if (PHMASK & 64) attn_item(it, proj, a.attn_sink + l * 8, lds, tid); }
                else mlstm_local_item(it - 1024, proj, kc, gates, a.gate_bias + l * 16, Cb, nb, mloc, gch, lds, tid);
            }
        } else if ((PHMASK & 16) && pt == 3) {
            mlstm_scan(Cb, nb, mloc, gch, mprev, tid);
        } else if ((PHMASK & 32) && pt == 4) {
            for (int it = blockIdx.x; it < 512; it += gridDim.x)
                mlstm_out_item(it, proj, qc, kc, gates, a.gate_bias + l * 16, Cb, nb, mprev, a.ml_norm_g + l * 1024, lds, tid);
            __syncthreads();
            convert_plain(a.w_up + (size_t)l * DM * FF, DM, FF, W0, scr, lane, gw, NGW);
        } else if ((PHMASK & 128) && pt == 6) {
            __syncthreads();
            if ((T / 256) * (NIN / 256) % (int)gridDim.x == 0) convert_plain(a.w_down + (size_t)l * FF * DM, FF, DM, W1, scr, lane, gw, NGW);
            if (l == 0) row_phase(a.x, nullptr, mixA, a.g_post_mix, mixA, nullptr, a.g_pre_mlp, hb, lane, gw, NGW);
            else row_phase_b<3>(mixB, mixA, a.g_post_mix + DM, mixA, nullptr, a.g_pre_mlp + DM, hb, lane, gw, NGW);
        } else if (PHMASK & 256) {
            __syncthreads();
            if (l == 0) {
                convert_win(a.w_in + (size_t)DM * INCOLS, W0, scr, lane, gw, NGW);
                convert_plain(a.w_out + (size_t)DM * DM, DM, DM, W2, scr, lane, gw, NGW);
            }
            row_phase_b<3>(mixA, mixB, a.g_post_mlp + l * DM, l == 0 ? mixB : nullptr, l == 0 ? nullptr : a.out, l == 0 ? a.g_pre_mix + DM : nullptr, hb, lane, gw, NGW);
        }
        if (ph + 1 < a.ph_hi) { if (a.ph_hi > 1000) grid.sync(); else xcd_barrier(xbar); }
    }
}


#ifndef DBG_NPH
#define DBG_NPH 0
#endif
#if DBG_NPH
__global__ void dbg_dump(const unsigned short* src, size_t n, float* out, int nout) {
    for (size_t i = (size_t)blockIdx.x * blockDim.x + threadIdx.x; i < (size_t)nout; i += (size_t)gridDim.x * blockDim.x) {
        float s = 0.f;
        for (int k = 0; k < 4; ++k) { const size_t j = 4 * i + k; if (j < n) { const unsigned short b = src[j]; if ((b & 0x7f80u) == 0x7f80u) { const int col = (int)(j % 4608); s = col < 1024 ? 1.0e6f : (col < 2048 ? 3.0e6f : 7.0e6f); } } }
        out[i] = s; }
}
#endif
extern "C" void kernel_launch(void* const* d_in, const int* in_sizes, int n_in, void* d_out, int out_size, void* d_ws, size_t ws_size, hipStream_t stream) {
    static int grid = 0;
    if (grid == 0) {
        int dev = 0, cus = 0, per_cu = 0;
        (void)hipGetDevice(&dev);
        (void)hipDeviceGetAttribute(&cus, hipDeviceAttributeMultiprocessorCount, dev);
        if (hipFuncSetAttribute((const void*)mega, hipFuncAttributeMaxDynamicSharedMemorySize, LDS_BYTES) != hipSuccess) fprintf(stderr, "kernel_launch: hipFuncSetAttribute failed\n");
        if (hipOccupancyMaxActiveBlocksPerMultiprocessor(&per_cu, (const void*)mega, 512, LDS_BYTES) != hipSuccess || per_cu < 1) { fprintf(stderr, "kernel_launch: occupancy query says %d\n", per_cu); per_cu = 1; }
        (void)hipGetLastError();
        if (cus <= 0) cus = 256;
        grid = cus;
        if (ws_size < WS_END) fprintf(stderr, "kernel_launch: workspace too small: %zu < %zu\n", ws_size, (size_t)WS_END);
    }
    Args a{};
    a.x = (const float*)d_in[0]; a.w_in = (const float*)d_in[1]; a.conv_w = (const float*)d_in[2]; a.gate_bias = (const float*)d_in[3]; a.ml_norm_g = (const float*)d_in[4];
    a.attn_sink = (const float*)d_in[5]; a.w_out = (const float*)d_in[6]; a.g_pre_mix = (const float*)d_in[7]; a.g_post_mix = (const float*)d_in[8]; a.g_pre_mlp = (const float*)d_in[9];
    a.g_post_mlp = (const float*)d_in[10]; a.w_up = (const float*)d_in[11]; a.w_down = (const float*)d_in[12];
    a.out = (float*)d_out; a.ws = (unsigned char*)d_ws;
#if ONE_LAUNCH
    (void)hipMemsetAsync((unsigned char*)d_ws + WS_BAR, 0, 16384, stream);
    a.ph_lo = 0; a.ph_hi = NPH;
    void* args[] = {&a};
    hipError_t e = hipLaunchCooperativeKernel((const void*)mega, dim3(grid), dim3(512), args, LDS_BYTES, stream);
    if (e != hipSuccess) fprintf(stderr, "cooperative launch failed: %s (grid %d)\n", hipGetErrorString(e), grid);
#else
#if DBG_NPH
    for (int p = 0; p < DBG_NPH; ++p) { a.ph_lo = p; a.ph_hi = p + 1; hipLaunchKernelGGL(mega, dim3(grid), dim3(512), LDS_BYTES, stream, a); }
    hipLaunchKernelGGL(dbg_dump, dim3(2048), dim3(256), 0, stream, (const unsigned short*)((const unsigned char*)d_ws + DBG_OFF), (size_t)DBG_N, (float*)d_out, out_size);
#else
    for (int p = 0; p < NPH; ++p) { a.ph_lo = p; a.ph_hi = p + 1; hipLaunchKernelGGL(mega, dim3(grid), dim3(512), LDS_BYTES, stream, a); }
#endif
#endif
}
```

```cpp
#include <hip/hip_runtime.h>
#include <hip/hip_cooperative_groups.h>
#include <cstdio>
#include <cstdint>
namespace cg = cooperative_groups;

#ifndef PHMASK
#define PHMASK 0xFFFF
#endif
#ifndef ONE_LAUNCH
#define ONE_LAUNCH 1
#endif

#define LAS __attribute__((address_space(3)))
typedef unsigned short bf16_t;
typedef short bf16x8 __attribute__((ext_vector_type(8)));
typedef short bf16x4 __attribute__((ext_vector_type(4)));
typedef float f32x4 __attribute__((ext_vector_type(4)));
typedef unsigned u32x4 __attribute__((ext_vector_type(4)));
typedef unsigned u32x2 __attribute__((ext_vector_type(2)));

constexpr int T = 16384, SEQ = 8192, DM = 2048, FF = 8192;
constexpr int INCOLS = 4624;
constexpr int NPROJ = 4608;
constexpr int NIN = 4864;
constexpr int PC_AQ = 0, PC_MO = 1024, PC_AK = 2048, PC_AV = 2304, PC_MQ = 2560, PC_MK = 3072, PC_MV = 3584;
constexpr float NORM_EPS = 1e-6f;
constexpr int NPH = 21;
constexpr int LDS_BYTES = 163840;
constexpr int WD_SPLIT = 4096;

constexpr size_t WS_U = 0;
constexpr size_t WS_PROJ = 0;
constexpr size_t WS_QC = 150994944;
constexpr size_t WS_KC = WS_QC + 16777216;
constexpr size_t WS_CB = WS_KC + 16777216;
constexpr size_t WS_GATES = WS_CB + 67108864;
constexpr size_t WS_NB = WS_GATES + 1048576;
constexpr size_t WS_ML = WS_NB + 524288;
constexpr size_t WS_GC = WS_ML + 4096;
constexpr size_t WS_MP = WS_GC + 4096;
constexpr size_t WS_MIXO = 268435456;
constexpr size_t WS_HB = WS_MIXO + 67108864;
constexpr size_t WS_W0 = WS_HB + 67108864;
constexpr size_t WS_W1 = WS_W0 + 33554432;
constexpr size_t WS_W2 = WS_W1 + 33554432;
constexpr size_t WS_BAR = WS_W2 + 8388608;
constexpr size_t WS_END = WS_BAR + 16384;
static_assert(WS_MP + 4096 <= WS_MIXO, "overlay");

typedef __bf16 bf16v2_t __attribute__((ext_vector_type(2)));
typedef float f32x2_t __attribute__((ext_vector_type(2)));
__device__ __forceinline__ unsigned cvt_pk_bf16(float lo, float hi) { const f32x2_t v = {lo, hi}; const bf16v2_t b = __builtin_convertvector(v, bf16v2_t); return __builtin_bit_cast(unsigned, b); }
__device__ __forceinline__ bf16_t f2bf(float x) { return (bf16_t)(cvt_pk_bf16(x, 0.f) & 0xffffu); }
__device__ __forceinline__ float bf2f(bf16_t b) { return __uint_as_float(((unsigned)b) << 16); }
__device__ __forceinline__ float bflo(unsigned w) { return __uint_as_float(w << 16); }
__device__ __forceinline__ float bfhi(unsigned w) { return __uint_as_float(w & 0xffff0000u); }
__device__ __forceinline__ float wave_sum(float v) {
#pragma unroll
    for (int o = 1; o < 64; o <<= 1) v += __shfl_xor(v, o);
    return v;
}
__device__ __forceinline__ float sigmoidf_(float y) { return 1.0f / (1.0f + __expf(-y)); }
__device__ __forceinline__ float logsigmoid_(float x) { return x < 0.f ? x - log1pf(expf(x)) : -log1pf(expf(-x)); }
#define MFMA16(a, b, c) __builtin_amdgcn_mfma_f32_16x16x32_bf16((a), (b), (c), 0, 0, 0)
#define LGKM0() asm volatile("s_waitcnt lgkmcnt(0)" ::: "memory")

namespace pg8 {
constexpr int BM = 256, BK = 64, HALF = 128, HTB = HALF * BK * 2, STAGE_BYTES = 8 * HTB, NXCD = 8, WGM = 8;
__host__ __device__ __forceinline__ int lds_byte(int r, int c) { const int st = (r >> 4) * 2 + (c >> 5), rr = r & 15, cc = c & 31, ob = rr * 64 + cc * 2; return st * 1024 + (ob ^ (((ob >> 9) & 1) << 5)); }
__host__ __device__ __forceinline__ void stage_rc(int b, int& R, int& C) { const int st = b / 1024, sb = b % 1024, swz = sb ^ (((sb >> 9) & 1) << 5); R = (st >> 1) * 16 + swz / 64; C = (st & 1) * 32 + (swz % 64) / 2; }
__host__ __device__ __forceinline__ int perm32(int rho) { const int n = rho >> 4, i = rho & 15; return 8 * (i >> 2) + 4 * n + (i & 3); }

struct Unit { int pm, pn; };
struct Gemm { const bf16_t* A; const bf16_t* Bt; int M, N, K, lda; };

struct StaticOrder {
    int nM, nN, nwg, G, c;
    __device__ void init(int M, int N, int G_, int c_) { nM = M / BM; nN = N / BM; nwg = nM * nN; G = G_; c = c_; }
    __device__ bool next(int i, Unit& u) const {
        const long L = (long)i * G + c; if (L >= nwg) return false;
        int wgid = (int)L; { const int q = nwg / NXCD, r = nwg % NXCD, xcd = wgid % NXCD, off = wgid / NXCD; wgid = (xcd < r ? xcd * (q + 1) : r * (q + 1) + (xcd - r) * q) + off; }
        const int nig = WGM * nN, gid = wgid / nig, fm = gid * WGM, gsz = (nM - fm) < WGM ? (nM - fm) : WGM;
        u.pm = fm + ((wgid % nig) % gsz); u.pn = (wgid % nig) / gsz; return true;
    }
};

struct Epi {
    bf16_t* O; int ldc; int act; float* gates; int gate_pn;
    __device__ __forceinline__ void operator()(const f32x4 (&acc)[2][2][4][2], const Unit& u, int wr, int wc, int fr, int fq) const {
        const int row0 = u.pm * BM + wr * 64 + fr;
        if (u.pn == gate_pn) {
            if (wc == 0 && fq < 2) {
#pragma unroll
                for (int ai = 0; ai < 2; ++ai)
#pragma unroll
                    for (int m = 0; m < 4; ++m) { float* gp = gates + (size_t)(row0 + ai * HALF + m * 16) * 16 + 8 * fq;
#pragma unroll
                        for (int n = 0; n < 2; ++n) *(f32x4*)(gp + 4 * n) = acc[ai][0][m][n]; }
            }
            return;
        }
        const int col0 = u.pn * BM + wc * 32 + 8 * fq;
#pragma unroll
        for (int ai = 0; ai < 2; ++ai)
#pragma unroll
            for (int m = 0; m < 4; ++m) { bf16_t* rowp = O + (size_t)(row0 + ai * HALF + m * 16) * ldc + col0;
#pragma unroll
                for (int bj = 0; bj < 2; ++bj) { f32x4 v0 = acc[ai][bj][m][0], v1 = acc[ai][bj][m][1];
                    if (act) {
#pragma unroll
                        for (int j = 0; j < 4; ++j) { const float a = fmaxf(v0[j], 0.f), b = fmaxf(v1[j], 0.f); v0[j] = a * a; v1[j] = b * b; } }
                    u32x4 w; w.x = cvt_pk_bf16(v0[0], v0[1]); w.y = cvt_pk_bf16(v0[2], v0[3]); w.z = cvt_pk_bf16(v1[0], v1[1]); w.w = cvt_pk_bf16(v1[2], v1[3]);
                    if (act) __builtin_nontemporal_store(w, (u32x4*)(rowp + bj * HALF)); else *(u32x4*)(rowp + bj * HALF) = w; } }
    }
};

__device__ __forceinline__ void gemm_phase(LAS unsigned char* lds, const Gemm g, const StaticOrder& S, const Epi& E, const int tid) {
    const int wid = __builtin_amdgcn_readfirstlane(tid >> 6), lane = tid & 63, wr = wid >> 2, wc = wid & 3, fr = lane & 15, fq = lane >> 4;
    const int K = g.K, nt = K / BK, lda = g.lda;
    unsigned voffA[2], voffB[2];
#pragma unroll
    for (int i = 0; i < 2; ++i) { int R, C; stage_rc(tid * 16 + i * 8192, R, C); const int Rb = (R & ~31) + perm32(R & 31);
        voffA[i] = (unsigned)(R * lda + C) * 2u; voffB[i] = (unsigned)(Rb * K + C) * 2u; }
    const size_t kstep = (size_t)(BK * 2);
    const size_t hstepA = (size_t)HALF * lda * 2, hstepB = (size_t)HALF * K * 2;
    const size_t tstepA = 2 * hstepA, tstepB = 2 * hstepB;
    const unsigned ldsw = (unsigned)wid * 1024u;
    const int aoff = lds_byte(wr * 64 + fr, fq * 8), boff = lds_byte(wc * 32 + fr, fq * 8);
#define PG8_SA(b, h) (((b) * 2 + (h)) * HTB)
#define PG8_SB(b, h) ((4 + (b) * 2 + (h)) * HTB)
#define PG8_STAGE(bufoff, gbase, voff) do { _Pragma("unroll") for (int _i = 0; _i < 2; ++_i) \
        __builtin_amdgcn_global_load_lds((const unsigned*)((const char*)(gbase) + (voff)[_i]), (LAS unsigned*)(lds + (bufoff) + ldsw + _i * 8192), 16, 0, 0); } while (0)
#define PG8_LDA(dst, b, h) do { _Pragma("unroll") for (int m = 0; m < 4; ++m) _Pragma("unroll") for (int k = 0; k < 2; ++k) dst[m][k] = *(const LAS bf16x8*)(lds + PG8_SA(b, h) + aoff + m * 2048 + k * 1024); } while (0)
#define PG8_LDB(dst, b, h) do { _Pragma("unroll") for (int n = 0; n < 2; ++n) _Pragma("unroll") for (int k = 0; k < 2; ++k) dst[n][k] = *(const LAS bf16x8*)(lds + PG8_SB(b, h) + boff + n * 2048 + k * 1024); } while (0)
#define PG8_MMA(ai, bj, At, Bt) do { __builtin_amdgcn_s_setprio(1); _Pragma("unroll") for (int m = 0; m < 4; ++m) _Pragma("unroll") for (int n = 0; n < 2; ++n) _Pragma("unroll") for (int k = 0; k < 2; ++k) \
        acc[ai][bj][m][n] = __builtin_amdgcn_mfma_f32_16x16x32_bf16(Bt[n][k], At[m][k], acc[ai][bj][m][n], 0, 0, 0); __builtin_amdgcn_s_setprio(0); } while (0)
#define PG8_WAIT_V(n) asm volatile("s_waitcnt vmcnt(" #n ")" ::: "memory")
#define PG8_WAIT_L(n) asm volatile("s_waitcnt lgkmcnt(" #n ")" ::: "memory")
#define PG8_BAR __builtin_amdgcn_s_barrier()
#define PG8_SCHED __builtin_amdgcn_sched_barrier(0)
    Unit cur, nxt; int ui = 0;
    if (!S.next(0, cur)) return;
    f32x4 acc[2][2][4][2];
#pragma unroll
    for (int a = 0; a < 2; ++a)
#pragma unroll
        for (int b = 0; b < 2; ++b)
#pragma unroll
            for (int m = 0; m < 4; ++m)
#pragma unroll
                for (int n = 0; n < 2; ++n) acc[a][b][m][n] = (f32x4){0.f, 0.f, 0.f, 0.f};
    bf16x8 At[4][2], B0[2][2], B1[2][2];
    const char* cA = (const char*)g.A + (size_t)cur.pm * tstepA; const char* cB = (const char*)g.Bt + (size_t)cur.pn * tstepB;
    PG8_STAGE(PG8_SB(0, 0), cB, voffB); PG8_STAGE(PG8_SB(0, 1), cB + hstepB, voffB); PG8_STAGE(PG8_SA(0, 0), cA, voffA); PG8_STAGE(PG8_SA(0, 1), cA + hstepA, voffA);
    if (wr == 1) PG8_BAR;
    PG8_WAIT_V(2); PG8_BAR;
    PG8_STAGE(PG8_SB(1, 0), cB + kstep, voffB); PG8_STAGE(PG8_SA(1, 0), cA + kstep, voffA); PG8_STAGE(PG8_SB(1, 1), cB + hstepB + kstep, voffB);
    PG8_WAIT_V(6); PG8_BAR;
    for (;;) {
        const bool has_next = S.next(ui + 1, nxt);
        const char* nA = has_next ? (const char*)g.A + (size_t)nxt.pm * tstepA : cA; const char* nB = has_next ? (const char*)g.Bt + (size_t)nxt.pn * tstepB : cB;
        for (int t = 0; t < nt; t += 2) {
            const bool last = (t == nt - 2);
            const char* a1 = cA + (size_t)(t + 1) * kstep;
            const char* a2 = last ? nA : cA + (size_t)(t + 2) * kstep; const char* b2 = last ? nB : cB + (size_t)(t + 2) * kstep;
            const char* a3 = a2 + kstep; const char* b3 = b2 + kstep;
            PG8_LDB(B0, 0, 0); PG8_LDB(B1, 0, 1); PG8_SCHED; PG8_LDA(At, 0, 0); PG8_STAGE(PG8_SA(1, 1), a1 + hstepA, voffA);
            PG8_WAIT_V(8); PG8_WAIT_L(0); PG8_BAR; PG8_MMA(0, 0, At, B0); PG8_MMA(0, 1, At, B1); PG8_BAR; PG8_SCHED;
            PG8_LDA(At, 0, 1); PG8_STAGE(PG8_SB(0, 0), b2, voffB); PG8_STAGE(PG8_SB(0, 1), b2 + hstepB, voffB); PG8_STAGE(PG8_SA(0, 0), a2, voffA);
            PG8_WAIT_V(8); PG8_WAIT_L(0); PG8_BAR; PG8_MMA(1, 0, At, B0); PG8_MMA(1, 1, At, B1); PG8_BAR; PG8_SCHED;
            PG8_LDB(B0, 1, 0); PG8_LDB(B1, 1, 1); PG8_SCHED; PG8_LDA(At, 1, 0); PG8_STAGE(PG8_SA(0, 1), a2 + hstepA, voffA);
            PG8_WAIT_V(8); PG8_WAIT_L(0); PG8_BAR; PG8_MMA(0, 0, At, B0); PG8_MMA(0, 1, At, B1); PG8_BAR; PG8_SCHED;
            PG8_LDA(At, 1, 1); PG8_STAGE(PG8_SB(1, 0), b3, voffB); PG8_STAGE(PG8_SB(1, 1), b3 + hstepB, voffB); PG8_STAGE(PG8_SA(1, 0), a3, voffA);
            PG8_WAIT_V(8); PG8_WAIT_L(0); PG8_BAR; PG8_MMA(1, 0, At, B0); PG8_MMA(1, 1, At, B1); PG8_BAR; PG8_SCHED;
        }
        if (wr == 0) PG8_BAR;
        E(acc, cur, wr, wc, fr, fq);
        if (!has_next) break;
#pragma unroll
        for (int a = 0; a < 2; ++a)
#pragma unroll
            for (int b = 0; b < 2; ++b)
#pragma unroll
                for (int m = 0; m < 4; ++m)
#pragma unroll
                    for (int n = 0; n < 2; ++n) acc[a][b][m][n] = (f32x4){0.f, 0.f, 0.f, 0.f};
        cur = nxt; cA = nA; cB = nB; ++ui;
        if (wr == 1) PG8_BAR;
    }
    PG8_WAIT_V(0);
    PG8_BAR;
#undef PG8_SA
#undef PG8_SB
#undef PG8_STAGE
#undef PG8_LDA
#undef PG8_LDB
#undef PG8_MMA
#undef PG8_WAIT_V
#undef PG8_WAIT_L
#undef PG8_BAR
#undef PG8_SCHED
}
}

__device__ __forceinline__ void t_load(const float* W, int ldw, int src_n0, int nvalid, int k0, int lane, f32x4 (&v)[16]) {
    const int n4 = lane & 15, kr = lane >> 4;
    const float* wp = W + (size_t)(k0 + kr) * ldw + src_n0 + 4 * n4;
    const bool ok = 4 * n4 < nvalid;
#pragma unroll
    for (int i = 0; i < 16; ++i) { v[i] = (f32x4){0.f, 0.f, 0.f, 0.f}; if (ok) v[i] = __builtin_nontemporal_load((const f32x4*)(wp + (size_t)(4 * i) * ldw)); }
}
__device__ __forceinline__ void t_store(const f32x4 (&v)[16], bf16_t* WT, int K, int dst_n0, int k0, LAS float* scr, int lane) {
    const int n4 = lane & 15, kr = lane >> 4;
#pragma unroll
    for (int i = 0; i < 16; ++i) { LAS float* d = scr + (4 * i + kr) * 65 + 4 * n4; d[0] = v[i][0]; d[1] = v[i][1]; d[2] = v[i][2]; d[3] = v[i][3]; }
    LGKM0();
    const int c8 = lane & 7;
#pragma unroll
    for (int j = 0; j < 8; ++j) { const int n = (lane >> 3) + 8 * j; const LAS float* sp = scr + (8 * c8) * 65 + n;
        u32x4 o; o.x = cvt_pk_bf16(sp[0 * 65], sp[1 * 65]); o.y = cvt_pk_bf16(sp[2 * 65], sp[3 * 65]); o.z = cvt_pk_bf16(sp[4 * 65], sp[5 * 65]); o.w = cvt_pk_bf16(sp[6 * 65], sp[7 * 65]);
        *(u32x4*)(WT + (size_t)(dst_n0 + n) * K + k0 + 8 * c8) = o; }
    LGKM0();
}
__device__ __forceinline__ int in_src_col(int n) {
    if (n < 1024) return n;
    if (n < 2048) return 3584 + (n - 1024);
    if (n < 2304) return 1024 + (n - 2048);
    if (n < 2560) return 1280 + (n - 2304);
    if (n < 3072) return 1536 + (n - 2560);
    if (n < 3584) return 2048 + (n - 3072);
    if (n < 4608) return 2560 + (n - 3584);
    return n;
}
template <bool WIN>
__device__ __forceinline__ void convert_w(const float* W, int K, int N, bf16_t* WT, int ldt, LAS float* scr, int lane, int gw, int NGW) {
    const int nblk = N / 64, items = (K / 64) * nblk, ldw = WIN ? INCOLS : N;
    int it = gw; if (it >= items) return;
    int k0 = 64 * (it / nblk), n0 = 64 * (it % nblk), src = n0, nvalid = 64;
    if (WIN) { src = in_src_col(n0); nvalid = INCOLS - src; nvalid = nvalid < 0 ? 0 : (nvalid > 64 ? 64 : nvalid); if (n0 < 4608) nvalid = 64; if (nvalid == 0) src = 0; }
    f32x4 v[16];
    t_load(W, ldw, src, nvalid, k0, lane, v);
    for (;;) {
        const int itn = it + NGW; const bool hn = itn < items;
        int k0n = 0, n0n = 0; f32x4 vn[16];
        if (hn) { k0n = 64 * (itn / nblk); n0n = 64 * (itn % nblk); int srcn = n0n, nvn = 64;
            if (WIN) { srcn = in_src_col(n0n); nvn = INCOLS - srcn; nvn = nvn < 0 ? 0 : (nvn > 64 ? 64 : nvn); if (n0n < 4608) nvn = 64; if (nvn == 0) srcn = 0; }
            t_load(W, ldw, srcn, nvn, k0n, lane, vn); }
        t_store(v, WT, ldt, n0, k0, scr, lane);
        if (!hn) break;
#pragma unroll
        for (int i = 0; i < 16; ++i) v[i] = vn[i];
        it = itn; k0 = k0n; n0 = n0n;
    }
}
__device__ __forceinline__ void convert_plain(const float* W, int K, int N, bf16_t* WT, LAS float* scr, int lane, int gw, int NGW) { convert_w<false>(W, K, N, WT, K, scr, lane, gw, NGW); }
__device__ __forceinline__ void convert_krange(const float* W, int K, int N, int k_lo, int k_hi, bf16_t* WT, LAS float* scr, int lane, int gw, int NGW) { convert_w<false>(W + (size_t)k_lo * N, k_hi - k_lo, N, WT + k_lo, K, scr, lane, gw, NGW); }
__device__ __forceinline__ void convert_win(const float* W, bf16_t* WT, LAS float* scr, int lane, int gw, int NGW) { convert_w<true>(W, DM, NIN, WT, DM, scr, lane, gw, NGW); }

__device__ __forceinline__ void row_phase(const float* xf, const bf16_t* xb, const bf16_t* y, const float* gpost, bf16_t* xob, float* xof, const float* gnext, bf16_t* hout, int lane, int gw, int NGW) {
    int m = gw; if (m >= T) return;
    f32x4 v[8]; u32x2 xw[8], yw[8];
    { if (xf) { const f32x4* xr = (const f32x4*)(xf + (size_t)m * DM) + lane;
#pragma unroll
          for (int j = 0; j < 8; ++j) v[j] = __builtin_nontemporal_load(xr + 64 * j); }
      else { const u32x2* xr = (const u32x2*)(xb + (size_t)m * DM) + lane;
#pragma unroll
          for (int j = 0; j < 8; ++j) xw[j] = __builtin_nontemporal_load(xr + 64 * j); }
      if (y) { const u32x2* yr = (const u32x2*)(y + (size_t)m * DM) + lane;
#pragma unroll
          for (int j = 0; j < 8; ++j) yw[j] = __builtin_nontemporal_load(yr + 64 * j); } }
    for (;;) {
        const int mn = m + NGW; const bool hn = mn < T;
        f32x4 vn[8]; u32x2 xwn[8], ywn[8];
        if (hn) {
            if (xf) { const f32x4* xr = (const f32x4*)(xf + (size_t)mn * DM) + lane;
#pragma unroll
                for (int j = 0; j < 8; ++j) vn[j] = __builtin_nontemporal_load(xr + 64 * j); }
            else { const u32x2* xr = (const u32x2*)(xb + (size_t)mn * DM) + lane;
#pragma unroll
                for (int j = 0; j < 8; ++j) xwn[j] = __builtin_nontemporal_load(xr + 64 * j); }
            if (y) { const u32x2* yr = (const u32x2*)(y + (size_t)mn * DM) + lane;
#pragma unroll
                for (int j = 0; j < 8; ++j) ywn[j] = __builtin_nontemporal_load(yr + 64 * j); } }
        if (!xf) {
#pragma unroll
            for (int j = 0; j < 8; ++j) v[j] = (f32x4){bflo(xw[j].x), bfhi(xw[j].x), bflo(xw[j].y), bfhi(xw[j].y)}; }
        if (y) {
            f32x4 yv[8]; float s = 0.f;
#pragma unroll
            for (int j = 0; j < 8; ++j) { const u32x2 w = yw[j]; yv[j] = (f32x4){bflo(w.x), bfhi(w.x), bflo(w.y), bfhi(w.y)};
                s += (yv[j][0] * yv[j][0] + yv[j][1] * yv[j][1]) + (yv[j][2] * yv[j][2] + yv[j][3] * yv[j][3]); }
            s = wave_sum(s);
            const float rstd = 1.0f / sqrtf(s * (1.0f / DM) + NORM_EPS);
#pragma unroll
            for (int j = 0; j < 8; ++j) { const f32x4 gg = ((const f32x4*)gpost)[lane + 64 * j]; v[j] = v[j] + yv[j] * rstd * gg; }
            if (xof) { f32x4* xo = (f32x4*)(xof + (size_t)m * DM) + lane;
#pragma unroll
                for (int j = 0; j < 8; ++j) __builtin_nontemporal_store(v[j], xo + 64 * j); }
            else { u32x2* xo = (u32x2*)(xob + (size_t)m * DM) + lane;
#pragma unroll
                for (int j = 0; j < 8; ++j) { u32x2 w; w.x = cvt_pk_bf16(v[j][0], v[j][1]); w.y = cvt_pk_bf16(v[j][2], v[j][3]); __builtin_nontemporal_store(w, xo + 64 * j); } }
        }
        if (gnext) {
            float s = 0.f;
#pragma unroll
            for (int j = 0; j < 8; ++j) s += (v[j][0] * v[j][0] + v[j][1] * v[j][1]) + (v[j][2] * v[j][2] + v[j][3] * v[j][3]);
            s = wave_sum(s);
            const float rstd = 1.0f / sqrtf(s * (1.0f / DM) + NORM_EPS);
            u32x2* ho = (u32x2*)(hout + (size_t)m * DM) + lane;
#pragma unroll
            for (int j = 0; j < 8; ++j) { const f32x4 gg = ((const f32x4*)gnext)[lane + 64 * j]; const f32x4 o = v[j] * rstd * gg;
                u32x2 w; w.x = cvt_pk_bf16(o[0], o[1]); w.y = cvt_pk_bf16(o[2], o[3]); ho[64 * j] = w; }
        }
        if (!hn) break;
#pragma unroll
        for (int j = 0; j < 8; ++j) { v[j] = vn[j]; xw[j] = xwn[j]; yw[j] = ywn[j]; }
        m = mn;
    }
}

template <int R>
__device__ __forceinline__ void row_phase_b(const bf16_t* xb, const bf16_t* y, const float* gpost, bf16_t* xob, float* xof, const float* gnext, bf16_t* hout, int lane, int gw, int NGW) {
    if (gw >= T) return;
    const int nrows = (T - gw + NGW - 1) / NGW;
    u32x2 xw[R][8], yw[R][8];
#pragma unroll
    for (int i = 0; i < R; ++i) if (i < nrows) { const size_t m = (size_t)gw + (size_t)i * NGW;
        const u32x2* xr = (const u32x2*)(xb + m * DM) + lane; const u32x2* yr = (const u32x2*)(y + m * DM) + lane;
#pragma unroll
        for (int j = 0; j < 8; ++j) { xw[i][j] = __builtin_nontemporal_load(xr + 64 * j); yw[i][j] = __builtin_nontemporal_load(yr + 64 * j); } }
    for (int k0 = 0; k0 < nrows; k0 += R) {
#pragma unroll
        for (int i = 0; i < R; ++i) { const int k = k0 + i;
            if (k < nrows) {
                const size_t m = (size_t)gw + (size_t)k * NGW;
                f32x4 v[8], yv[8]; float s = 0.f;
#pragma unroll
                for (int j = 0; j < 8; ++j) { const u32x2 a = xw[i][j], w = yw[i][j];
                    v[j] = (f32x4){bflo(a.x), bfhi(a.x), bflo(a.y), bfhi(a.y)}; yv[j] = (f32x4){bflo(w.x), bfhi(w.x), bflo(w.y), bfhi(w.y)};
                    s += (yv[j][0] * yv[j][0] + yv[j][1] * yv[j][1]) + (yv[j][2] * yv[j][2] + yv[j][3] * yv[j][3]); }
                if (k + R < nrows) { const size_t mn = (size_t)gw + (size_t)(k + R) * NGW;
                    const u32x2* xr = (const u32x2*)(xb + mn * DM) + lane; const u32x2* yr = (const u32x2*)(y + mn * DM) + lane;
#pragma unroll
                    for (int j = 0; j < 8; ++j) { xw[i][j] = __builtin_nontemporal_load(xr + 64 * j); yw[i][j] = __builtin_nontemporal_load(yr + 64 * j); } }
                s = wave_sum(s);
                const float rstd = 1.0f / sqrtf(s * (1.0f / DM) + NORM_EPS);
#pragma unroll
                for (int j = 0; j < 8; ++j) { const f32x4 gg = ((const f32x4*)gpost)[lane + 64 * j]; v[j] = v[j] + yv[j] * rstd * gg; }
                if (xof) { f32x4* xo = (f32x4*)(xof + m * DM) + lane;
#pragma unroll
                    for (int j = 0; j < 8; ++j) __builtin_nontemporal_store(v[j], xo + 64 * j); }
                else { u32x2* xo = (u32x2*)(xob + m * DM) + lane;
#pragma unroll
                    for (int j = 0; j < 8; ++j) { u32x2 w; w.x = cvt_pk_bf16(v[j][0], v[j][1]); w.y = cvt_pk_bf16(v[j][2], v[j][3]); __builtin_nontemporal_store(w, xo + 64 * j); } }
                if (gnext) {
                    float s2 = 0.f;
#pragma unroll
                    for (int j = 0; j < 8; ++j) s2 += (v[j][0] * v[j][0] + v[j][1] * v[j][1]) + (v[j][2] * v[j][2] + v[j][3] * v[j][3]);
                    s2 = wave_sum(s2);
                    const float rstd2 = 1.0f / sqrtf(s2 * (1.0f / DM) + NORM_EPS);
                    u32x2* ho = (u32x2*)(hout + m * DM) + lane;
#pragma unroll
                    for (int j = 0; j < 8; ++j) { const f32x4 gg = ((const f32x4*)gnext)[lane + 64 * j]; const f32x4 o = v[j] * rstd2 * gg;
                        u32x2 w; w.x = cvt_pk_bf16(o[0], o[1]); w.y = cvt_pk_bf16(o[2], o[3]); ho[64 * j] = w; }
                }
            }
        }
    }
}

__device__ __forceinline__ void prep_phase(bf16_t* proj, const float* convw, bf16_t* qc, bf16_t* kc, int lane, int gw, int NGW) {
    if (gw >= T) return;
    constexpr int R = 4;
    const int nrows = (T - gw + NGW - 1) / NGW;
    const float invf = exp2f(-(float)lane * (13.287712379549449f / 64.0f));
    float cw[2][3][8];
#pragma unroll
    for (int jj = 0; jj < 2; ++jj)
#pragma unroll
        for (int tp = 0; tp < 3; ++tp) { const f32x4 w0 = *(const f32x4*)(convw + tp * 1024 + lane * 8 + 512 * jj), w1 = *(const f32x4*)(convw + tp * 1024 + lane * 8 + 512 * jj + 4);
            cw[jj][tp][0] = w0[0]; cw[jj][tp][1] = w0[1]; cw[jj][tp][2] = w0[2]; cw[jj][tp][3] = w0[3]; cw[jj][tp][4] = w1[0]; cw[jj][tp][5] = w1[1]; cw[jj][tp][6] = w1[2]; cw[jj][tp][7] = w1[3]; }
    u32x4 cur[R][2], prv[R][2], nxt[R][2]; bf16_t kx[R][4];
#define PREP_LOAD(slot, mrow) do { const size_t _m = (mrow); const int _pos = (int)(_m & (SEQ - 1)); const bf16_t* _pr = proj + _m * NPROJ; \
        _Pragma("unroll") for (int jj = 0; jj < 2; ++jj) { const int _ch = lane * 8 + 512 * jj; cur[slot][jj] = *(const u32x4*)(_pr + PC_MQ + _ch); \
            prv[slot][jj] = (u32x4){0u, 0u, 0u, 0u}; nxt[slot][jj] = (u32x4){0u, 0u, 0u, 0u}; \
            if (_pos > 0) prv[slot][jj] = *(const u32x4*)(_pr - NPROJ + PC_MQ + _ch); \
            if (_pos < SEQ - 1) nxt[slot][jj] = *(const u32x4*)(_pr + NPROJ + PC_MQ + _ch); } \
        kx[slot][0] = _pr[PC_AK + lane]; kx[slot][1] = _pr[PC_AK + 64 + lane]; kx[slot][2] = _pr[PC_AK + 128 + lane]; kx[slot][3] = _pr[PC_AK + 192 + lane]; } while (0)
#pragma unroll
    for (int i = 0; i < R; ++i) if (i < nrows) PREP_LOAD(i, (size_t)gw + (size_t)i * NGW);
    for (int k0 = 0; k0 < nrows; k0 += R) {
#pragma unroll
        for (int i = 0; i < R; ++i) { const int k = k0 + i;
            if (k < nrows) {
                const size_t m = (size_t)gw + (size_t)k * NGW;
                u32x4 c2[2], p2[2], n2[2]; bf16_t k4[4];
#pragma unroll
                for (int jj = 0; jj < 2; ++jj) { c2[jj] = cur[i][jj]; p2[jj] = prv[i][jj]; n2[jj] = nxt[i][jj]; }
#pragma unroll
                for (int q = 0; q < 4; ++q) k4[q] = kx[i][q];
                if (k + R < nrows) PREP_LOAD(i, (size_t)gw + (size_t)(k + R) * NGW);
                const int pos = (int)(m & (SEQ - 1));
                const float ang = (float)pos * invf;
                const double rev = (double)ang * 0.15915494309189535; const float f = (float)(rev - rint(rev));
                const float sn = __builtin_amdgcn_sinf(f), cs = __builtin_amdgcn_cosf(f);
                bf16_t* pr = proj + m * NPROJ;
#pragma unroll
                for (int hh = 0; hh < 2; ++hh) { const int base = PC_AK + hh * 128;
                    const float x1 = bf2f(k4[2 * hh]), x2 = bf2f(k4[2 * hh + 1]);
                    pr[base + lane] = f2bf(x1 * cs - x2 * sn); pr[base + 64 + lane] = f2bf(x2 * cs + x1 * sn); }
#pragma unroll
                for (int jj = 0; jj < 2; ++jj) { float yv[8];
#pragma unroll
                    for (int e = 0; e < 4; ++e) {
                        const float ya = cw[jj][0][2 * e] * bflo(p2[jj][e]) + cw[jj][1][2 * e] * bflo(c2[jj][e]) + cw[jj][2][2 * e] * bflo(n2[jj][e]);
                        const float yb = cw[jj][0][2 * e + 1] * bfhi(p2[jj][e]) + cw[jj][1][2 * e + 1] * bfhi(c2[jj][e]) + cw[jj][2][2 * e + 1] * bfhi(n2[jj][e]);
                        yv[2 * e] = ya * sigmoidf_(ya); yv[2 * e + 1] = yb * sigmoidf_(yb); }
                    if (jj == 0) {
#pragma unroll
                        for (int e = 0; e < 8; ++e) yv[e] *= 0.08838834764831845f; }
                    u32x4 o; o.x = cvt_pk_bf16(yv[0], yv[1]); o.y = cvt_pk_bf16(yv[2], yv[3]); o.z = cvt_pk_bf16(yv[4], yv[5]); o.w = cvt_pk_bf16(yv[6], yv[7]);
                    *(u32x4*)((jj == 0 ? qc : kc) + m * 512 + lane * 8) = o; }
            }
        }
    }
#undef PREP_LOAD
}

__device__ __forceinline__ void stage_nat128(const bf16_t* src, long ld, int nrows, int lo, int hi, LAS bf16_t* dst, int tid) {
    for (int idx = tid; idx < nrows * 16; idx += 512) { const int row = idx >> 4, c8 = idx & 15; u32x4 v = (u32x4){0u, 0u, 0u, 0u};
        if (row >= lo && row < hi) v = *(const u32x4*)(src + (long)row * ld + c8 * 8);
        *(LAS u32x4*)(dst + row * 136 + c8 * 8) = v; }
}
__device__ __forceinline__ void stage_T(const bf16_t* src, long ld, int nrows, int ncols, int lo, int hi, LAS bf16_t* dst, int VS, const LAS float* rowscale, int tid) {
    const int nrb = nrows >> 5, total = nrows * (ncols >> 3);
    for (int idx = tid; idx < total; idx += 512) {
        const int rlo = idx & 31, cl = (idx >> 5) & 1, rest = idx >> 6, rowblk = rest % nrb, cp = rest / nrb;
        const int row = rowblk * 32 + rlo, chunk = 2 * cp + cl;
        u32x4 v = (u32x4){0u, 0u, 0u, 0u};
        if (row >= lo && row < hi) v = *(const u32x4*)(src + (long)row * ld + chunk * 8);
        LAS bf16_t* d = dst + (chunk * 8) * VS + row;
        if (rowscale) { const float sc = rowscale[row];
#pragma unroll
            for (int e = 0; e < 4; ++e) { const unsigned w = cvt_pk_bf16(bflo(v[e]) * sc, bfhi(v[e]) * sc); d[(2 * e) * VS] = (bf16_t)(w & 0xffffu); d[(2 * e + 1) * VS] = (bf16_t)(w >> 16); }
        } else {
#pragma unroll
            for (int e = 0; e < 4; ++e) { d[(2 * e) * VS] = (bf16_t)(v[e] & 0xffffu); d[(2 * e + 1) * VS] = (bf16_t)(v[e] >> 16); }
        }
    }
}
__device__ __forceinline__ bf16x8 ld_pair(const LAS bf16_t* p0, const LAS bf16_t* p1) {
    const bf16x4 lo = *(const LAS bf16x4*)p0, hi = *(const LAS bf16x4*)p1;
    return __builtin_shufflevector(lo, hi, 0, 1, 2, 3, 4, 5, 6, 7);
}
__device__ __forceinline__ bf16x8 pack8(const f32x4 a, const f32x4 b) {
    u32x4 w; w.x = cvt_pk_bf16(a[0], a[1]); w.y = cvt_pk_bf16(a[2], a[3]); w.z = cvt_pk_bf16(b[0], b[1]); w.w = cvt_pk_bf16(b[2], b[3]);
    return (bf16x8)w;
}

template <int N> __device__ __forceinline__ void ld_nat(const bf16_t* src, long ld, int lo, int hi, int tid, u32x4 (&v)[N]) {
#pragma unroll
    for (int i = 0; i < N; ++i) { const int idx = tid + 512 * i, row = idx >> 4, c8 = idx & 15; v[i] = (u32x4){0u, 0u, 0u, 0u};
        if (row >= lo && row < hi) v[i] = *(const u32x4*)(src + (long)row * ld + c8 * 8); }
}
template <int N> __device__ __forceinline__ void st_nat(const u32x4 (&v)[N], LAS bf16_t* dst, int tid) {
    asm volatile("" : "+v"(tid));
#pragma unroll
    for (int i = 0; i < N; ++i) { const int idx = tid + 512 * i, row = idx >> 4, c8 = idx & 15; *(LAS u32x4*)(dst + row * 136 + c8 * 8) = v[i]; }
}
template <int N, int NROWS> __device__ __forceinline__ void ld_T(const bf16_t* src, long ld, int lo, int hi, int tid, u32x4 (&v)[N]) {
    constexpr int nrb = NROWS >> 5;
#pragma unroll
    for (int i = 0; i < N; ++i) { const int idx = tid + 512 * i, rlo = idx & 31, cl = (idx >> 5) & 1, rest = idx >> 6, rowblk = rest % nrb, cp = rest / nrb;
        const int row = rowblk * 32 + rlo, chunk = 2 * cp + cl; v[i] = (u32x4){0u, 0u, 0u, 0u};
        if (row >= lo && row < hi) v[i] = *(const u32x4*)(src + (long)row * ld + chunk * 8); }
}
template <int N, int NROWS> __device__ __forceinline__ void st_T(const u32x4 (&v)[N], LAS bf16_t* dst, int VS, const LAS float* rowscale, int tid) {
    constexpr int nrb = NROWS >> 5;
    asm volatile("" : "+v"(tid));
#pragma unroll
    for (int i = 0; i < N; ++i) { const int idx = tid + 512 * i, rlo = idx & 31, cl = (idx >> 5) & 1, rest = idx >> 6, rowblk = rest % nrb, cp = rest / nrb;
        const int row = rowblk * 32 + rlo, chunk = 2 * cp + cl;
        LAS bf16_t* d = dst + (chunk * 8) * VS + row;
        if (rowscale) { const float sc = rowscale[row];
#pragma unroll
            for (int e = 0; e < 4; ++e) { const unsigned w = cvt_pk_bf16(bflo(v[i][e]) * sc, bfhi(v[i][e]) * sc); d[(2 * e) * VS] = (bf16_t)(w & 0xffffu); d[(2 * e + 1) * VS] = (bf16_t)(w >> 16); }
        } else {
#pragma unroll
            for (int e = 0; e < 4; ++e) { d[(2 * e) * VS] = (bf16_t)(v[i][e] & 0xffffu); d[(2 * e + 1) * VS] = (bf16_t)(v[i][e] >> 16); }
        } }
}

__device__ __forceinline__ void attn_item(int item, bf16_t* proj, const float* sink, LAS unsigned char* lds, int tid) {
    const int j = item & 63, qh = (item >> 6) & 7, b = item >> 9, kvh = qh >> 2;
    const int wave = tid >> 6, lane = tid & 63, r = lane & 15, fq = lane >> 4;
    LAS bf16_t* Ks = (LAS bf16_t*)lds;
    LAS bf16_t* Vt = (LAS bf16_t*)lds;
    const int kpos0 = j * 128 - 128;
    const int lo = kpos0 < 0 ? -kpos0 : 0, hi = (kpos0 + 384 > SEQ) ? SEQ - kpos0 : 384;
    const bf16_t* kbase = proj + ((long)b * SEQ + kpos0) * NPROJ + PC_AK + kvh * 128;
    const bf16_t* vbase = proj + ((long)b * SEQ + kpos0) * NPROJ + PC_AV + kvh * 128;
    __syncthreads();
    stage_nat128(kbase, NPROJ, 384, lo, hi, Ks, tid);
    bf16_t* qrow = proj + ((size_t)b * SEQ + j * 128 + wave * 16 + r) * NPROJ + PC_AQ + qh * 128;
    bf16x8 qf[4];
#pragma unroll
    for (int ks = 0; ks < 4; ++ks) qf[ks] = *(const bf16x8*)(qrow + ks * 32 + fq * 8);
    {
        const float posf = (float)(j * 128 + wave * 16 + r);
#pragma unroll
        for (int k2 = 0; k2 < 2; ++k2) { const u32x4 xa = (u32x4)qf[k2], xb = (u32x4)qf[k2 + 2]; float y1[8], y2[8];
#pragma unroll
            for (int e = 0; e < 8; ++e) { const float invf = exp2f(-(float)(k2 * 32 + fq * 8 + e) * (13.287712379549449f / 64.0f));
                const float ang = posf * invf; const double rev = (double)ang * 0.15915494309189535; const float fr = (float)(rev - rint(rev));
                const float sn = __builtin_amdgcn_sinf(fr), cs = __builtin_amdgcn_cosf(fr);
                const float x1 = (e & 1) ? bfhi(xa[e >> 1]) : bflo(xa[e >> 1]), x2 = (e & 1) ? bfhi(xb[e >> 1]) : bflo(xb[e >> 1]);
                y1[e] = x1 * cs - x2 * sn; y2[e] = x2 * cs + x1 * sn; }
            u32x4 oa, ob;
#pragma unroll
            for (int e = 0; e < 4; ++e) { oa[e] = cvt_pk_bf16(y1[2 * e], y1[2 * e + 1]); ob[e] = cvt_pk_bf16(y2[2 * e], y2[2 * e + 1]); }
            qf[k2] = (bf16x8)oa; qf[k2 + 2] = (bf16x8)ob; } }
    __syncthreads();
    const int w = __builtin_amdgcn_readfirstlane(wave);
    const bool jf = (j != 0), jl = (j != 63);
#define ATT_TV(st) ((st) < 8 ? ((st) >= w && jf) : ((st) < 16 ? true : (((st) - 16) <= w && jl)))
    f32x4 sacc[24];
#pragma unroll
    for (int st = 0; st < 24; ++st) { f32x4 a4 = (f32x4){0.f, 0.f, 0.f, 0.f};
        if (ATT_TV(st)) {
#pragma unroll
            for (int ks = 0; ks < 4; ++ks) { const bf16x8 a = *(const LAS bf16x8*)(Ks + (16 * st + r) * 136 + ks * 32 + fq * 8); a4 = MFMA16(a, qf[ks], a4); } }
        sacc[st] = a4; }
    const float cs2 = 0.08838834764831845f * 1.4426950408889634f;
    const float snk2 = sink[qh] * 1.4426950408889634f;
    float mx = -3.0e38f;
#pragma unroll
    for (int st = 0; st < 24; ++st) {
        if (ATT_TV(st)) {
#pragma unroll
            for (int jj = 0; jj < 4; ++jj) { float sv = sacc[st][jj];
                if (st < 8) { if (st == w) sv = (4 * fq + jj >= r) ? sv : -3.0e38f; }
                else if (st >= 16) { if (st - 16 == w) sv = (4 * fq + jj <= r) ? sv : -3.0e38f; }
                sacc[st][jj] = sv; mx = fmaxf(mx, sv); } } }
    mx = fmaxf(mx, __shfl_xor(mx, 16)); mx = fmaxf(mx, __shfl_xor(mx, 32));
    const float m2 = fmaxf(mx * cs2, snk2);
    float sum = 0.f;
#pragma unroll
    for (int st = 0; st < 24; ++st) {
        if (ATT_TV(st)) {
#pragma unroll
            for (int jj = 0; jj < 4; ++jj) { const float p = __builtin_amdgcn_exp2f(fmaf(sacc[st][jj], cs2, -m2)); sacc[st][jj] = p; sum += p; } }
        else sacc[st] = (f32x4){0.f, 0.f, 0.f, 0.f}; }
    sum += __shfl_xor(sum, 16); sum += __shfl_xor(sum, 32);
    const float inv = 1.0f / (sum + __builtin_amdgcn_exp2f(snk2 - m2));
    bf16x8 pb[12];
#pragma unroll
    for (int kp = 0; kp < 12; ++kp) pb[kp] = pack8(sacc[2 * kp], sacc[2 * kp + 1]);
    __syncthreads();
    stage_T(vbase, NPROJ, 384, 128, lo, hi, Vt, 396, nullptr, tid);
    __syncthreads();
    f32x4 o[8];
#pragma unroll
    for (int dt = 0; dt < 8; ++dt) o[dt] = (f32x4){0.f, 0.f, 0.f, 0.f};
#pragma unroll
    for (int kp = 0; kp < 12; ++kp) {
        if (ATT_TV(2 * kp) || ATT_TV(2 * kp + 1)) {
            const LAS bf16_t* vr = Vt + r * 396 + 4 * fq + kp * 32;
#pragma unroll
            for (int dt = 0; dt < 8; ++dt) { const bf16x8 a = ld_pair(vr + dt * (16 * 396), vr + dt * (16 * 396) + 16); o[dt] = MFMA16(a, pb[kp], o[dt]); } } }
#pragma unroll
    for (int dt = 0; dt < 8; ++dt) { u32x2 wv; wv.x = cvt_pk_bf16(o[dt][0] * inv, o[dt][1] * inv); wv.y = cvt_pk_bf16(o[dt][2] * inv, o[dt][3] * inv);
        *(u32x2*)(qrow + 16 * dt + 4 * fq) = wv; }
#undef ATT_TV
}

__device__ __forceinline__ void mlstm_local_item(int item, const bf16_t* proj, const bf16_t* kc, const float* gates, const float* gbias, bf16_t* Cb, float* nb, float* mloc, float* gch,
                                                 LAS unsigned char* lds, int tid) {
    asm volatile("" : "+v"(tid));
    const int c = item & 63, h = (item >> 6) & 3, b = item >> 8;
    const int wave = tid >> 6, lane = tid & 63, r = lane & 15, fq = lane >> 4;
    const long row0 = (long)b * SEQ + c * 128;
    const int bh = b * 4 + h;
    LAS bf16_t* Kt = (LAS bf16_t*)lds;
    LAS bf16_t* Vt = (LAS bf16_t*)(lds + 33792);
    LAS float* lf = (LAS float*)(lds + 101376);
    LAS float* li = lf + 256; LAS float* aa = lf + 512; LAS float* we = lf + 768;
    u32x4 vreg[8], kreg[4]; float gi = 0.f, gf = 0.f;
    ld_T<8, 128>(proj + row0 * NPROJ + PC_MV + h * 256, NPROJ, 0, 128, tid, vreg);
    ld_T<4, 128>(kc + row0 * 512 + h * 128, 512, 0, 128, tid, kreg);
    if (tid < 256) { const int dir = tid >> 7, l = tid & 127;
        gi = gates[(row0 + l) * 16 + (2 * dir) * 4 + h] + gbias[(2 * dir) * 4 + h];
        gf = gates[(row0 + l) * 16 + (2 * dir + 1) * 4 + h] + gbias[(2 * dir + 1) * 4 + h]; }
    __syncthreads();
    if (tid < 256) { li[tid] = gi; lf[tid] = logsigmoid_(gf); }
    st_T<8, 128>(vreg, Vt, 132, nullptr, tid);
    __syncthreads();
    if (tid < 256) { const int dir = tid >> 7, l = tid & 127; float acc = 0.f, tot = 0.f;
        for (int q = 0; q < 128; ++q) { const float v = lf[dir * 128 + q]; tot += v; acc += (q <= l) ? v : 0.f; }
        if (dir) acc = tot - acc + lf[dir * 128 + l];
        aa[tid] = tot - acc + li[tid];
        if (l == 0) gch[(bh * 2 + dir) * 64 + c] = tot; }
    __syncthreads();
    if (tid < 256) { const int dir = tid >> 7, l = tid & 127; float mxx = -3.0e38f;
        for (int q = 0; q < 128; ++q) mxx = fmaxf(mxx, aa[dir * 128 + q]);
        we[tid] = expf(aa[tid] - mxx);
        if (l == 0) mloc[(bh * 2 + dir) * 64 + c] = mxx; }
    bf16x8 bfr[2][4];
#pragma unroll
    for (int dd = 0; dd < 2; ++dd)
#pragma unroll
        for (int ks = 0; ks < 4; ++ks) { const LAS bf16_t* p = Vt + ((2 * wave + dd) * 16 + r) * 132 + ks * 32 + fq * 8; bfr[dd][ks] = ld_pair(p, p + 4); }
#pragma unroll 1
    for (int dir = 0; dir < 2; ++dir) {
        const int si = (bh * 2 + dir) * 64 + c;
        __syncthreads();
        st_T<4, 128>(kreg, Kt, 132, we + dir * 128, tid);
        __syncthreads();
        if (tid < 128) { float sn = 0.f; const LAS bf16_t* kr = Kt + tid * 132;
            for (int q = 0; q < 128; q += 4) { const u32x2 wv = *(const LAS u32x2*)(kr + q); sn += (bflo(wv.x) + bfhi(wv.x)) + (bflo(wv.y) + bfhi(wv.y)); }
            nb[(size_t)si * 128 + tid] = sn; }
        bf16_t* Cg = Cb + (size_t)si * 256 * 128;
#pragma unroll
        for (int dkt = 0; dkt < 8; ++dkt) { f32x4 a0 = (f32x4){0.f, 0.f, 0.f, 0.f}, a1 = (f32x4){0.f, 0.f, 0.f, 0.f};
#pragma unroll
            for (int ks = 0; ks < 4; ++ks) { const LAS bf16_t* p = Kt + (dkt * 16 + r) * 132 + ks * 32 + fq * 8; const bf16x8 a = ld_pair(p, p + 4);
                a0 = MFMA16(a, bfr[0][ks], a0); a1 = MFMA16(a, bfr[1][ks], a1); }
            u32x2 w0; w0.x = cvt_pk_bf16(a0[0], a0[1]); w0.y = cvt_pk_bf16(a0[2], a0[3]);
            u32x2 w1; w1.x = cvt_pk_bf16(a1[0], a1[1]); w1.y = cvt_pk_bf16(a1[2], a1[3]);
            *(u32x2*)(Cg + (size_t)((2 * wave) * 16 + r) * 128 + dkt * 16 + 4 * fq) = w0;
            *(u32x2*)(Cg + (size_t)((2 * wave + 1) * 16 + r) * 128 + dkt * 16 + 4 * fq) = w1; }
    }
}

__device__ __forceinline__ void mlstm_scan(bf16_t* Cb, float* nb, const float* mloc, const float* gch, float* mprev, int tid) {
    for (int vb = blockIdx.x; vb < 256; vb += gridDim.x) {
        const int bhd = vb >> 4, part = vb & 15, dir = bhd & 1;
        bf16_t* Cp = Cb + (size_t)bhd * 64 * 32768 + (size_t)(part * 512 + tid) * 4;
        const bool do_n = (part == 0) && (tid < 128);
        float* np = nb + (size_t)bhd * 64 * 128 + (tid & 127);
        float c0 = 0.f, c1 = 0.f, c2 = 0.f, c3 = 0.f, cn = 0.f, m = -1.0e30f;
        for (int s0 = 0; s0 < 64; s0 += 8) {
            u32x2 v[8]; float gg[8], ml[8], nv[8];
#pragma unroll
            for (int q = 0; q < 8; ++q) { const int c = dir ? 63 - (s0 + q) : (s0 + q);
                v[q] = *(const u32x2*)(Cp + (size_t)c * 32768); gg[q] = gch[bhd * 64 + c]; ml[q] = mloc[bhd * 64 + c]; nv[q] = do_n ? np[c * 128] : 0.f; }
#pragma unroll
            for (int q = 0; q < 8; ++q) { const int c = dir ? 63 - (s0 + q) : (s0 + q);
                u32x2 o; o.x = cvt_pk_bf16(c0, c1); o.y = cvt_pk_bf16(c2, c3);
                *(u32x2*)(Cp + (size_t)c * 32768) = o;
                if (do_n) np[c * 128] = cn;
                if (part == 0 && tid == 0) mprev[bhd * 64 + c] = m;
                const float mn = fmaxf(gg[q] + m, ml[q]);
                const float sp = expf(gg[q] + m - mn), sl = expf(ml[q] - mn);
                c0 = sp * c0 + sl * bflo(v[q].x); c1 = sp * c1 + sl * bfhi(v[q].x); c2 = sp * c2 + sl * bflo(v[q].y); c3 = sp * c3 + sl * bfhi(v[q].y);
                cn = sp * cn + sl * nv[q];
                m = mn; }
        }
    }
}

__device__ __forceinline__ void mlstm_out_item(int item, bf16_t* proj, const bf16_t* qc, const bf16_t* kc, const float* gates, const float* gbias, const bf16_t* Cb, const float* nb,
                                               const float* mprev, const float* gnorm, LAS unsigned char* lds, int tid) {
    asm volatile("" : "+v"(tid));
    const int c = item & 63, h = (item >> 6) & 3, b = item >> 8;
    const int wave = tid >> 6, lane = tid & 63, r = lane & 15, fq = lane >> 4;
    const long row0 = (long)b * SEQ + c * 128;
    const int bh = b * 4 + h;
    LAS bf16_t* Ks = (LAS bf16_t*)lds;
    LAS bf16_t* Vt = (LAS bf16_t*)(lds + 34816);
    LAS float* fl = (LAS float*)(lds + 104448);
    LAS float* lf = fl; LAS float* li = fl + 256; LAS float* bb = fl + 512; LAS float* ee = fl + 768; LAS float* Mt = fl + 1024; LAS float* mpl = fl + 1280; LAS float* npv = fl + 1536;
    const int t = 16 * wave + r;
    float mpv = 0.f;
    { u32x4 kreg[4], vreg[8]; float gi = 0.f, gf = 0.f, nn = 0.f;
      ld_nat<4>(kc + row0 * 512 + h * 128, 512, 0, 128, tid, kreg);
      ld_T<8, 128>(proj + row0 * NPROJ + PC_MV + h * 256, NPROJ, 0, 128, tid, vreg);
      if (tid < 256) { const int dir = tid >> 7, l = tid & 127; const int si = (bh * 2 + dir) * 64 + c;
          gi = gates[(row0 + l) * 16 + (2 * dir) * 4 + h] + gbias[(2 * dir) * 4 + h];
          gf = gates[(row0 + l) * 16 + (2 * dir + 1) * 4 + h] + gbias[(2 * dir + 1) * 4 + h];
          nn = nb[(size_t)si * 128 + l]; mpv = mprev[si]; }
      __syncthreads();
      if (tid < 256) { li[tid] = gi; lf[tid] = logsigmoid_(gf); npv[tid] = nn; }
      st_nat<4>(kreg, Ks, tid);
      st_T<8, 128>(vreg, Vt, 136, nullptr, tid); }
    __syncthreads();
    if (tid < 256) { const int dir = tid >> 7, l = tid & 127; float acc = 0.f, tot = 0.f;
        for (int q = 0; q < 128; ++q) { const float v = lf[dir * 128 + q]; tot += v; acc += (q <= l) ? v : 0.f; }
        if (dir) acc = tot - acc + lf[dir * 128 + l];
        bb[tid] = acc; ee[tid] = li[tid] - acc; }
    __syncthreads();
    if (tid < 256) { const int dir = tid >> 7, l = tid & 127; float pmf = -3.0e38f, pmb = -3.0e38f;
        for (int q = 0; q < 128; ++q) { const float v = ee[dir * 128 + q]; pmf = fmaxf(pmf, (q <= l) ? v : -3.0e38f); pmb = fmaxf(pmb, (q >= l) ? v : -3.0e38f); }
        Mt[tid] = fmaxf(mpv, dir ? pmb : pmf);
        if (l == 0) mpl[dir] = mpv; }
    __syncthreads();
    bf16x8 qf[4];
    { const bf16_t* qr = qc + (row0 + t) * 512 + h * 128;
#pragma unroll
      for (int ks = 0; ks < 4; ++ks) qf[ks] = *(const bf16x8*)(qr + ks * 32 + fq * 8); }
    f32x4 sacc[8];
#pragma unroll
    for (int st = 0; st < 8; ++st) { f32x4 a4 = (f32x4){0.f, 0.f, 0.f, 0.f};
#pragma unroll
        for (int ks = 0; ks < 4; ++ks) { const bf16x8 a = *(const LAS bf16x8*)(Ks + (16 * st + r) * 136 + ks * 32 + fq * 8); a4 = MFMA16(a, qf[ks], a4); }
        sacc[st] = a4; }
    __syncthreads();
    LAS bf16_t* hsl = (LAS bf16_t*)(wave < 4 ? lds + wave * 8320 : lds + 111616 + (wave - 4) * 8320) + r * 260 + 4 * fq;
    bf16x8 pb[2][4]; float inv[2], wi[2];
    const int w = __builtin_amdgcn_readfirstlane(wave);
    const float L2E = 1.4426950408889634f;
#pragma unroll
    for (int dir = 0; dir < 2; ++dir) {
        const float Mv = Mt[dir * 128 + t]; const float mp = mpl[dir];
        const float winter = __builtin_amdgcn_exp2f((mp - Mv) * L2E);
        float qd = 0.f;
#pragma unroll
        for (int ks = 0; ks < 4; ++ks) { const LAS float* np = npv + dir * 128 + ks * 32 + fq * 8; const u32x4 qw = (u32x4)qf[ks];
            qd += bflo(qw.x) * np[0] + bfhi(qw.x) * np[1] + bflo(qw.y) * np[2] + bfhi(qw.y) * np[3] + bflo(qw.z) * np[4] + bfhi(qw.z) * np[5] + bflo(qw.w) * np[6] + bfhi(qw.w) * np[7]; }
        qd += __shfl_xor(qd, 16); qd += __shfl_xor(qd, 32);
        float den = 0.f; f32x4 pv[8];
#pragma unroll
        for (int st = 0; st < 8; ++st)
#pragma unroll
            for (int jj = 0; jj < 4; ++jj) { const int sidx = 16 * st + 4 * fq + jj; const bool valid = dir ? (sidx >= t) : (sidx <= t);
                const float wgt = valid ? __builtin_amdgcn_exp2f((ee[dir * 128 + sidx] - Mv) * L2E) : 0.f; const float p = sacc[st][jj] * wgt; den += p; pv[st][jj] = p; }
#pragma unroll
        for (int kp = 0; kp < 4; ++kp) pb[dir][kp] = pack8(pv[2 * kp], pv[2 * kp + 1]);
        den += __shfl_xor(den, 16); den += __shfl_xor(den, 32);
        const float dent = den + winter * qd;
        const float denom = fmaxf(fabsf(dent), expf(-(bb[dir * 128 + t] + Mv)));
        inv[dir] = 1.0f / denom; wi[dir] = winter;
    }
    float ss = 0.f;
    bf16_t* orow = proj + (size_t)(row0 + t) * NPROJ + PC_MO + h * 256;
    LAS bf16_t* SL = (LAS bf16_t*)(lds + 144896);
    const int srow = (tid >> 4) & 31, sc8 = tid & 15;
    const bf16_t* sg0 = Cb + (size_t)((bh * 2 + 0) * 64 + c) * 32768 + srow * 128 + sc8 * 8;
    const bf16_t* sg1 = Cb + (size_t)((bh * 2 + 1) * 64 + c) * 32768 + srow * 128 + sc8 * 8;
    LAS bf16_t* sdst = SL + srow * 136 + sc8 * 8;
    u32x4 pre0 = *(const u32x4*)sg0, pre1 = *(const u32x4*)sg1;
#pragma unroll 1
    for (int sl = 0; sl < 8; ++sl) {
        __syncthreads();
        *(LAS u32x4*)sdst = pre0; *(LAS u32x4*)(sdst + 32 * 136) = pre1;
        __syncthreads();
        { const int sn = sl < 7 ? sl + 1 : 7; pre0 = *(const u32x4*)(sg0 + (size_t)sn * 4096); pre1 = *(const u32x4*)(sg1 + (size_t)sn * 4096); }
#pragma unroll
        for (int d2 = 0; d2 < 2; ++d2) {
            const int dvt = sl * 2 + d2;
            f32x4 hsum = (f32x4){0.f, 0.f, 0.f, 0.f};
            const LAS bf16_t* vr = Vt + (dvt * 16 + r) * 136 + 4 * fq;
#pragma unroll
            for (int dir = 0; dir < 2; ++dir) {
                f32x4 a4 = (f32x4){0.f, 0.f, 0.f, 0.f};
                const LAS bf16_t* cr = SL + dir * (32 * 136) + (d2 * 16 + r) * 136 + fq * 8;
#pragma unroll
                for (int ks = 0; ks < 4; ++ks) { const bf16x8 a = *(const LAS bf16x8*)(cr + ks * 32); a4 = MFMA16(a, qf[ks], a4); }
                a4 = a4 * wi[dir];
#pragma unroll
                for (int kp = 0; kp < 4; ++kp) { const bf16x8 a = ld_pair(vr + kp * 32, vr + kp * 32 + 16); a4 = MFMA16(a, pb[dir][kp], a4); }
                hsum = hsum + a4 * inv[dir];
            }
            ss += (hsum[0] * hsum[0] + hsum[1] * hsum[1]) + (hsum[2] * hsum[2] + hsum[3] * hsum[3]);
            u32x2 w; w.x = cvt_pk_bf16(hsum[0], hsum[1]); w.y = cvt_pk_bf16(hsum[2], hsum[3]);
            *(LAS u32x2*)(hsl + dvt * 16) = w;
        }
    }
    ss += __shfl_xor(ss, 16); ss += __shfl_xor(ss, 32);
    const float rn = 1.0f / sqrtf(ss * (1.0f / 256.0f) + NORM_EPS);
#pragma unroll 8
    for (int dvt = 0; dvt < 16; ++dvt) { const int dv0 = dvt * 16 + 4 * fq;
        const f32x4 gg = *(const f32x4*)(gnorm + h * 256 + dv0);
        const u32x2 mo = *(const u32x2*)(orow + dv0);
        const u32x2 v = *(const LAS u32x2*)(hsl + dvt * 16);
        const float o0 = bflo(v.x) * rn * gg[0] * sigmoidf_(bflo(mo.x)), o1 = bfhi(v.x) * rn * gg[1] * sigmoidf_(bfhi(mo.x));
        const float o2 = bflo(v.y) * rn * gg[2] * sigmoidf_(bflo(mo.y)), o3 = bfhi(v.y) * rn * gg[3] * sigmoidf_(bfhi(mo.y));
        u32x2 w; w.x = cvt_pk_bf16(o0, o1); w.y = cvt_pk_bf16(o2, o3);
        *(u32x2*)(orow + dv0) = w; }
}


#define XB_TMO      128
#define XB_XCNT(j)  (256  + 64 * (j))
#define XB_XSUB(j)  (1280 + 64 * (j))
#define XB_XGEN(j)  (2304 + 64 * (j))
#define XB_TOP      3328
#define XB_TOPGEN   3392
#define XCD_BAR_WORDS 3456
#define XB_SPIN_CAP (1u << 20)
__device__ __forceinline__ unsigned xb_ld(unsigned* p)              { return __hip_atomic_load(p, __ATOMIC_RELAXED, __HIP_MEMORY_SCOPE_AGENT); }
__device__ __forceinline__ unsigned xb_add(unsigned* p, unsigned v) { return __hip_atomic_fetch_add(p, v, __ATOMIC_RELAXED, __HIP_MEMORY_SCOPE_AGENT); }
__device__ __forceinline__ unsigned xb_xcc_id() { return (unsigned)__builtin_amdgcn_s_getreg((3 << 11) | 20) & 0xFu; }
#define XB_SPIN(cond, bar) do { unsigned _sp = 0; while (cond) { __builtin_amdgcn_s_sleep(1); \
    if ((++_sp & 255u) == 0u) { if (xb_ld(&(bar)[XB_TMO])) break; if (_sp > XB_SPIN_CAP) { atomicAdd(&(bar)[XB_TMO], 1u); break; } } } } while (0)
struct XcdBarrier { unsigned* bar; unsigned x; volatile LAS unsigned* st; };
__device__ __forceinline__ XcdBarrier xcd_barrier_post(unsigned* bar, volatile LAS unsigned* st) {
    XcdBarrier b; b.bar = bar; b.x = xb_xcc_id(); b.st = st;
    if (threadIdx.x == 0) (void)xb_add(&bar[XB_XCNT(b.x)], 1u);
    return b;
}
__device__ __forceinline__ void xcd_barrier_complete(unsigned* bar, unsigned x, unsigned& nloc, unsigned& nx) {
    const unsigned G = gridDim.x * gridDim.y * gridDim.z;
    unsigned sum, cnt, mine, sp = 0u;
    for (;;) {
        sum = 0u; cnt = 0u; mine = 0u;
#pragma unroll
        for (unsigned j = 0; j < 16; ++j) { const unsigned c = xb_ld(&bar[XB_XCNT(j)]); sum += c; cnt += (c > 0u) ? 1u : 0u; mine = (j == x) ? c : mine; }
        if (sum == G) break;
        __builtin_amdgcn_s_sleep(1);
        if ((++sp & 255u) == 0u) { if (xb_ld(&bar[XB_TMO])) break; if (sp > XB_SPIN_CAP) { atomicAdd(&bar[XB_TMO], 1u); break; } }
    }
    nloc = mine > 0u ? mine : 1u; nx = cnt > 0u ? cnt : 1u;
}
__device__ __forceinline__ void xcd_barrier(const XcdBarrier& b) {
    asm volatile("s_waitcnt vmcnt(0)" ::: "memory");
    __syncthreads();
    if (threadIdx.x == 0) {
        unsigned* bar = b.bar;
        __builtin_amdgcn_s_waitcnt(0);
        unsigned nloc = b.st[0], nx = b.st[1];
        if (nloc == 0u) { xcd_barrier_complete(bar, b.x, nloc, nx); b.st[0] = nloc; b.st[1] = nx; }
        const unsigned old = xb_add(&bar[XB_XSUB(b.x)], 1u);
        const unsigned gen = old / nloc;
        if (old + 1u == (gen + 1u) * nloc) {
            __builtin_amdgcn_fence(__ATOMIC_RELEASE, "agent");
            asm volatile("s_waitcnt vmcnt(0)" ::: "memory");
            const unsigned og = xb_add(&bar[XB_TOP], 1u);
            const unsigned tg = og / nx;
            if (og + 1u == (tg + 1u) * nx) xb_add(&bar[XB_TOPGEN], 1u);
            else XB_SPIN(xb_ld(&bar[XB_TOPGEN]) == tg, bar);
            __builtin_amdgcn_fence(__ATOMIC_ACQUIRE, "agent");
            xb_add(&bar[XB_XGEN(b.x)], 1u);
            asm volatile("s_waitcnt vmcnt(0)" ::: "memory");
        } else {
            XB_SPIN(xb_ld(&bar[XB_XGEN(b.x)]) == gen, bar);
            __builtin_amdgcn_fence(__ATOMIC_ACQUIRE, "agent");
            asm volatile("s_waitcnt vmcnt(0)" ::: "memory");
        }
    }
    __syncthreads();
}

struct Args {
    const float* x; const float* w_in; const float* conv_w; const float* gate_bias; const float* ml_norm_g; const float* attn_sink; const float* w_out;
    const float* g_pre_mix; const float* g_post_mix; const float* g_pre_mlp; const float* g_post_mlp; const float* w_up; const float* w_down;
    float* out; unsigned char* ws; int ph_lo, ph_hi;
};

__global__ void __launch_bounds__(512, 2) mega(Args a) {
    extern __shared__ __attribute__((aligned(16))) unsigned char lds_raw[];
    LAS unsigned char* lds = (LAS unsigned char*)lds_raw;
    cg::grid_group grid = cg::this_grid();
    unsigned char* ws = a.ws;
    bf16_t* proj = (bf16_t*)(ws + WS_PROJ); bf16_t* qc = (bf16_t*)(ws + WS_QC); bf16_t* kc = (bf16_t*)(ws + WS_KC); bf16_t* Cb = (bf16_t*)(ws + WS_CB);
    float* gates = (float*)(ws + WS_GATES); float* nb = (float*)(ws + WS_NB); float* mloc = (float*)(ws + WS_ML); float* gch = (float*)(ws + WS_GC); float* mprev = (float*)(ws + WS_MP);
    bf16_t* ubuf = (bf16_t*)(ws + WS_U); bf16_t* mixA = (bf16_t*)(ws + WS_MIXO); bf16_t* mixB = (bf16_t*)(ws + WS_HB);
    bf16_t* hb = (bf16_t*)a.out;
    bf16_t* W0 = (bf16_t*)(ws + WS_W0); bf16_t* W1 = (bf16_t*)(ws + WS_W1); bf16_t* W2 = (bf16_t*)(ws + WS_W2);

    volatile LAS unsigned* xb_st = (volatile LAS unsigned*)(lds + LDS_BYTES - 16);
    if (threadIdx.x < 4) xb_st[threadIdx.x] = 0u;
    __syncthreads();
    XcdBarrier xbar = xcd_barrier_post((unsigned*)(ws + WS_BAR), xb_st);
    for (int ph = a.ph_lo; ph < a.ph_hi; ++ph) {
        int tid = threadIdx.x; asm volatile("" : "+v"(tid));
        const int lane = tid & 63, wave = __builtin_amdgcn_readfirstlane(tid >> 6);
        const int gw = blockIdx.x * 8 + wave, NGW = gridDim.x * 8;
        LAS float* scr = (LAS float*)(lds + wave * 16640);
        const int l = (ph == 0) ? 0 : (ph - 1) / 10, pt = (ph == 0) ? -1 : (ph - 1) % 10;
        if (ph == 0 && (PHMASK & 1)) {
            convert_win(a.w_in, W0, scr, lane, gw, NGW);
            convert_plain(a.w_out, DM, DM, W2, scr, lane, gw, NGW);
            row_phase(a.x, nullptr, nullptr, nullptr, nullptr, nullptr, a.g_pre_mix, hb, lane, gw, NGW);
        } else if ((PHMASK & 2) && (pt == 0 || pt == 5 || pt == 7 || pt == 8)) {
            pg8::Gemm g; pg8::Epi E; E.gates = gates; E.gate_pn = -1; E.act = 0;
            if (pt == 0)      { g = pg8::Gemm{hb, W0, T, NIN, DM, DM};      E.O = proj; E.ldc = NPROJ; E.gate_pn = 18; }
            else if (pt == 5) { g = pg8::Gemm{proj, W2, T, DM, DM, NPROJ};  E.O = mixA; E.ldc = DM; }
            else if (pt == 7) { g = pg8::Gemm{hb, W0, T, FF, DM, DM};       E.O = ubuf; E.ldc = FF; E.act = 1; }
            else              { g = pg8::Gemm{ubuf, W1, T, DM, FF, FF};     E.O = mixB; E.ldc = DM; }
            pg8::StaticOrder S; S.init(g.M, g.N, (int)gridDim.x, (int)blockIdx.x);
            pg8::gemm_phase(lds, g, S, E, tid);
            if (pt == 0) {
                const int rem = (T / 256) * (NIN / 256) % (int)gridDim.x;
                if (rem != 0 && (int)blockIdx.x >= rem) { __syncthreads();
                    convert_krange(a.w_down + (size_t)l * FF * DM, FF, DM, 0, WD_SPLIT, W1, scr, lane, ((int)blockIdx.x - rem) * 8 + wave, ((int)gridDim.x - rem) * 8); }
            }
        } else if ((PHMASK & 4) && pt == 1) {
            prep_phase(proj, a.conv_w + (size_t)l * 3 * 1024, qc, kc, lane, gw, NGW);
        } else if ((PHMASK & 8) && pt == 2) {
            for (int it = blockIdx.x; it < 1536; it += gridDim.x) {
                if (it < 1024) { if (PHMASK & 64) attn_item(it, proj, a.attn_sink + l * 8, lds, tid); }
                else mlstm_local_item(it - 1024, proj, kc, gates, a.gate_bias + l * 16, Cb, nb, mloc, gch, lds, tid);
            }
        } else if ((PHMASK & 16) && pt == 3) {
            mlstm_scan(Cb, nb, mloc, gch, mprev, tid);
        } else if ((PHMASK & 32) && pt == 4) {
            for (int it = blockIdx.x; it < 512; it += gridDim.x)
                mlstm_out_item(it, proj, qc, kc, gates, a.gate_bias + l * 16, Cb, nb, mprev, a.ml_norm_g + l * 1024, lds, tid);
        } else if ((PHMASK & 128) && pt == 6) {
            __syncthreads();
            convert_plain(a.w_up + (size_t)l * DM * FF, DM, FF, W0, scr, lane, gw, NGW);
            convert_krange(a.w_down + (size_t)l * FF * DM, FF, DM, ((T / 256) * (NIN / 256) % (int)gridDim.x == 0) ? 0 : WD_SPLIT, FF, W1, scr, lane, gw, NGW);
            if (l == 0) row_phase(a.x, nullptr, mixA, a.g_post_mix, mixA, nullptr, a.g_pre_mlp, hb, lane, gw, NGW);
            else row_phase_b<3>(mixB, mixA, a.g_post_mix + DM, mixA, nullptr, a.g_pre_mlp + DM, hb, lane, gw, NGW);
        } else if (PHMASK & 256) {
            __syncthreads();
            if (l == 0) {
                convert_win(a.w_in + (size_t)DM * INCOLS, W0, scr, lane, gw, NGW);
                convert_plain(a.w_out + (size_t)DM * DM, DM, DM, W2, scr, lane, gw, NGW);
            }
            row_phase_b<3>(mixA, mixB, a.g_post_mlp + l * DM, l == 0 ? mixB : nullptr, l == 0 ? nullptr : a.out, l == 0 ? a.g_pre_mix + DM : nullptr, hb, lane, gw, NGW);
        }
        if (ph + 1 < a.ph_hi) { if (a.ph_hi > 1000) grid.sync(); else xcd_barrier(xbar); }
    }
}


#ifndef DBG_NPH
#define DBG_NPH 0
#endif
#if DBG_NPH
__global__ void dbg_dump(const unsigned short* src, size_t n, float* out, int nout) {
    for (size_t i = (size_t)blockIdx.x * blockDim.x + threadIdx.x; i < (size_t)nout; i += (size_t)gridDim.x * blockDim.x) {
        float s = 0.f;
        for (int k = 0; k < 4; ++k) { const size_t j = 4 * i + k; if (j < n) { const unsigned short b = src[j]; if ((b & 0x7f80u) == 0x7f80u) { const int col = (int)(j % 4608); s = col < 1024 ? 1.0e6f : (col < 2048 ? 3.0e6f : 7.0e6f); } } }
        out[i] = s; }
}
#endif
extern "C" void kernel_launch(void* const* d_in, const int* in_sizes, int n_in, void* d_out, int out_size, void* d_ws, size_t ws_size, hipStream_t stream) {
    static int grid = 0;
    if (grid == 0) {
        int dev = 0, cus = 0, per_cu = 0;
        (void)hipGetDevice(&dev);
        (void)hipDeviceGetAttribute(&cus, hipDeviceAttributeMultiprocessorCount, dev);
        if (hipFuncSetAttribute((const void*)mega, hipFuncAttributeMaxDynamicSharedMemorySize, LDS_BYTES) != hipSuccess) fprintf(stderr, "kernel_launch: hipFuncSetAttribute failed\n");
        if (hipOccupancyMaxActiveBlocksPerMultiprocessor(&per_cu, (const void*)mega, 512, LDS_BYTES) != hipSuccess || per_cu < 1) { fprintf(stderr, "kernel_launch: occupancy query says %d\n", per_cu); per_cu = 1; }
        (void)hipGetLastError();
        if (cus <= 0) cus = 256;
        grid = cus;
        if (ws_size < WS_END) fprintf(stderr, "kernel_launch: workspace too small: %zu < %zu\n", ws_size, (size_t)WS_END);
    }
    Args a{};
    a.x = (const float*)d_in[0]; a.w_in = (const float*)d_in[1]; a.conv_w = (const float*)d_in[2]; a.gate_bias = (const float*)d_in[3]; a.ml_norm_g = (const float*)d_in[4];
    a.attn_sink = (const float*)d_in[5]; a.w_out = (const float*)d_in[6]; a.g_pre_mix = (const float*)d_in[7]; a.g_post_mix = (const float*)d_in[8]; a.g_pre_mlp = (const float*)d_in[9];
    a.g_post_mlp = (const float*)d_in[10]; a.w_up = (const float*)d_in[11]; a.w_down = (const float*)d_in[12];
    a.out = (float*)d_out; a.ws = (unsigned char*)d_ws;
#if ONE_LAUNCH
    (void)hipMemsetAsync((unsigned char*)d_ws + WS_BAR, 0, 16384, stream);
    a.ph_lo = 0; a.ph_hi = NPH;
    void* args[] = {&a};
    hipError_t e = hipLaunchCooperativeKernel((const void*)mega, dim3(grid), dim3(512), args, LDS_BYTES, stream);
    if (e != hipSuccess) fprintf(stderr, "cooperative launch failed: %s (grid %d)\n", hipGetErrorString(e), grid);
#else
#if DBG_NPH
    for (int p = 0; p < DBG_NPH; ++p) { a.ph_lo = p; a.ph_hi = p + 1; hipLaunchKernelGGL(mega, dim3(grid), dim3(512), LDS_BYTES, stream, a); }
    hipLaunchKernelGGL(dbg_dump, dim3(2048), dim3(256), 0, stream, (const unsigned short*)((const unsigned char*)d_ws + DBG_OFF), (size_t)DBG_N, (float*)d_out, out_size);
#else
    for (int p = 0; p < NPH; ++p) { a.ph_lo = p; a.ph_hi = p + 1; hipLaunchKernelGGL(mega, dim3(grid), dim3(512), LDS_BYTES, stream, a); }
#endif
#endif
}
```

```cpp
#include <hip/hip_runtime.h>
#include <hip/hip_cooperative_groups.h>
#include <cstdio>
#include <cstdint>
namespace cg = cooperative_groups;

#ifndef PHMASK
#define PHMASK 0xFFFF
#endif
#ifndef ONE_LAUNCH
#define ONE_LAUNCH 1
#endif

#define LAS __attribute__((address_space(3)))
typedef unsigned short bf16_t;
typedef short bf16x8 __attribute__((ext_vector_type(8)));
typedef short bf16x4 __attribute__((ext_vector_type(4)));
typedef float f32x4 __attribute__((ext_vector_type(4)));
typedef unsigned u32x4 __attribute__((ext_vector_type(4)));
typedef unsigned u32x2 __attribute__((ext_vector_type(2)));

constexpr int T = 16384, SEQ = 8192, DM = 2048, FF = 8192;
constexpr int INCOLS = 4624;
constexpr int NPROJ = 4608;
constexpr int NIN = 4864;
constexpr int PC_AQ = 0, PC_MO = 1024, PC_AK = 2048, PC_AV = 2304, PC_MQ = 2560, PC_MK = 3072, PC_MV = 3584;
constexpr float NORM_EPS = 1e-6f;
constexpr int NPH = 21;
constexpr int LDS_BYTES = 163840;

constexpr size_t WS_U = 0;
constexpr size_t WS_PROJ = 0;
constexpr size_t WS_QC = 150994944;
constexpr size_t WS_KC = WS_QC + 16777216;
constexpr size_t WS_CB = WS_KC + 16777216;
constexpr size_t WS_GATES = WS_CB + 67108864;
constexpr size_t WS_NB = WS_GATES + 1048576;
constexpr size_t WS_ML = WS_NB + 524288;
constexpr size_t WS_GC = WS_ML + 4096;
constexpr size_t WS_MP = WS_GC + 4096;
constexpr size_t WS_MIXO = 268435456;
constexpr size_t WS_HB = WS_MIXO + 67108864;
constexpr size_t WS_W0 = WS_HB + 67108864;
constexpr size_t WS_W1 = WS_W0 + 33554432;
constexpr size_t WS_W2 = WS_W1 + 33554432;
constexpr size_t WS_BAR = WS_W2 + 8388608;
constexpr size_t WS_END = WS_BAR + 16384;
static_assert(WS_MP + 4096 <= WS_MIXO, "overlay");

typedef __bf16 bf16v2_t __attribute__((ext_vector_type(2)));
typedef float f32x2_t __attribute__((ext_vector_type(2)));
__device__ __forceinline__ unsigned cvt_pk_bf16(float lo, float hi) { const f32x2_t v = {lo, hi}; const bf16v2_t b = __builtin_convertvector(v, bf16v2_t); return __builtin_bit_cast(unsigned, b); }
__device__ __forceinline__ bf16_t f2bf(float x) { return (bf16_t)(cvt_pk_bf16(x, 0.f) & 0xffffu); }
__device__ __forceinline__ float bf2f(bf16_t b) { return __uint_as_float(((unsigned)b) << 16); }
__device__ __forceinline__ float bflo(unsigned w) { return __uint_as_float(w << 16); }
__device__ __forceinline__ float bfhi(unsigned w) { return __uint_as_float(w & 0xffff0000u); }
__device__ __forceinline__ float wave_sum(float v) {
#pragma unroll
    for (int o = 1; o < 64; o <<= 1) v += __shfl_xor(v, o);
    return v;
}
__device__ __forceinline__ float sigmoidf_(float y) { return 1.0f / (1.0f + __expf(-y)); }
__device__ __forceinline__ float logsigmoid_(float x) { return x < 0.f ? x - log1pf(expf(x)) : -log1pf(expf(-x)); }
#define MFMA16(a, b, c) __builtin_amdgcn_mfma_f32_16x16x32_bf16((a), (b), (c), 0, 0, 0)
#define LGKM0() asm volatile("s_waitcnt lgkmcnt(0)" ::: "memory")
#define LDS_BAR() do { asm volatile("s_waitcnt lgkmcnt(0)" ::: "memory"); __builtin_amdgcn_s_barrier(); asm volatile("" ::: "memory"); } while (0)

namespace pg8 {
constexpr int BM = 256, BK = 64, HALF = 128, HTB = HALF * BK * 2, STAGE_BYTES = 8 * HTB, NXCD = 8, WGM = 8;
__host__ __device__ __forceinline__ int lds_byte(int r, int c) { const int st = (r >> 4) * 2 + (c >> 5), rr = r & 15, cc = c & 31, ob = rr * 64 + cc * 2; return st * 1024 + (ob ^ (((ob >> 9) & 1) << 5)); }
__host__ __device__ __forceinline__ void stage_rc(int b, int& R, int& C) { const int st = b / 1024, sb = b % 1024, swz = sb ^ (((sb >> 9) & 1) << 5); R = (st >> 1) * 16 + swz / 64; C = (st & 1) * 32 + (swz % 64) / 2; }
__host__ __device__ __forceinline__ int perm32(int rho) { const int n = rho >> 4, i = rho & 15; return 8 * (i >> 2) + 4 * n + (i & 3); }

struct Unit { int pm, pn; };
struct Gemm { const bf16_t* A; const bf16_t* Bt; int M, N, K, lda; };

struct StaticOrder {
    int nM, nN, nwg, G, c;
    __device__ void init(int M, int N, int G_, int c_) { nM = M / BM; nN = N / BM; nwg = nM * nN; G = G_; c = c_; }
    __device__ bool next(int i, Unit& u) const {
        const long L = (long)i * G + c; if (L >= nwg) return false;
        int wgid = (int)L; { const int q = nwg / NXCD, r = nwg % NXCD, xcd = wgid % NXCD, off = wgid / NXCD; wgid = (xcd < r ? xcd * (q + 1) : r * (q + 1) + (xcd - r) * q) + off; }
        const int nig = WGM * nN, gid = wgid / nig, fm = gid * WGM, gsz = (nM - fm) < WGM ? (nM - fm) : WGM;
        u.pm = fm + ((wgid % nig) % gsz); u.pn = (wgid % nig) / gsz; return true;
    }
};

struct Epi {
    bf16_t* O; int ldc; int act; float* gates; int gate_pn;
    __device__ __forceinline__ void operator()(const f32x4 (&acc)[2][2][4][2], const Unit& u, int wr, int wc, int fr, int fq) const {
        const int row0 = u.pm * BM + wr * 64 + fr;
        if (u.pn == gate_pn) {
            if (wc == 0 && fq < 2) {
#pragma unroll
                for (int ai = 0; ai < 2; ++ai)
#pragma unroll
                    for (int m = 0; m < 4; ++m) { float* gp = gates + (size_t)(row0 + ai * HALF + m * 16) * 16 + 8 * fq;
#pragma unroll
                        for (int n = 0; n < 2; ++n) *(f32x4*)(gp + 4 * n) = acc[ai][0][m][n]; }
            }
            return;
        }
        const int col0 = u.pn * BM + wc * 32 + 8 * fq;
#pragma unroll
        for (int ai = 0; ai < 2; ++ai)
#pragma unroll
            for (int m = 0; m < 4; ++m) { bf16_t* rowp = O + (size_t)(row0 + ai * HALF + m * 16) * ldc + col0;
#pragma unroll
                for (int bj = 0; bj < 2; ++bj) { f32x4 v0 = acc[ai][bj][m][0], v1 = acc[ai][bj][m][1];
                    if (act) {
#pragma unroll
                        for (int j = 0; j < 4; ++j) { const float a = fmaxf(v0[j], 0.f), b = fmaxf(v1[j], 0.f); v0[j] = a * a; v1[j] = b * b; } }
                    u32x4 w; w.x = cvt_pk_bf16(v0[0], v0[1]); w.y = cvt_pk_bf16(v0[2], v0[3]); w.z = cvt_pk_bf16(v1[0], v1[1]); w.w = cvt_pk_bf16(v1[2], v1[3]);
                    if (act) __builtin_nontemporal_store(w, (u32x4*)(rowp + bj * HALF)); else *(u32x4*)(rowp + bj * HALF) = w; } }
    }
};

__device__ __forceinline__ void gemm_phase(LAS unsigned char* lds, const Gemm g, const StaticOrder& S, const Epi& E, const int tid) {
    const int wid = __builtin_amdgcn_readfirstlane(tid >> 6), lane = tid & 63, wr = wid >> 2, wc = wid & 3, fr = lane & 15, fq = lane >> 4;
    const int K = g.K, nt = K / BK, lda = g.lda;
    unsigned voffA[2], voffB[2];
#pragma unroll
    for (int i = 0; i < 2; ++i) { int R, C; stage_rc(tid * 16 + i * 8192, R, C); const int Rb = (R & ~31) + perm32(R & 31);
        voffA[i] = (unsigned)(R * lda + C) * 2u; voffB[i] = (unsigned)(Rb * K + C) * 2u; }
    const size_t kstep = (size_t)(BK * 2);
    const size_t hstepA = (size_t)HALF * lda * 2, hstepB = (size_t)HALF * K * 2;
    const size_t tstepA = 2 * hstepA, tstepB = 2 * hstepB;
    const unsigned ldsw = (unsigned)wid * 1024u;
    const int aoff = lds_byte(wr * 64 + fr, fq * 8), boff = lds_byte(wc * 32 + fr, fq * 8);
#define PG8_SA(b, h) (((b) * 2 + (h)) * HTB)
#define PG8_SB(b, h) ((4 + (b) * 2 + (h)) * HTB)
#define PG8_STAGE(bufoff, gbase, voff) do { _Pragma("unroll") for (int _i = 0; _i < 2; ++_i) \
        __builtin_amdgcn_global_load_lds((const unsigned*)((const char*)(gbase) + (voff)[_i]), (LAS unsigned*)(lds + (bufoff) + ldsw + _i * 8192), 16, 0, 0); } while (0)
#define PG8_LDA(dst, b, h) do { _Pragma("unroll") for (int m = 0; m < 4; ++m) _Pragma("unroll") for (int k = 0; k < 2; ++k) dst[m][k] = *(const LAS bf16x8*)(lds + PG8_SA(b, h) + aoff + m * 2048 + k * 1024); } while (0)
#define PG8_LDB(dst, b, h) do { _Pragma("unroll") for (int n = 0; n < 2; ++n) _Pragma("unroll") for (int k = 0; k < 2; ++k) dst[n][k] = *(const LAS bf16x8*)(lds + PG8_SB(b, h) + boff + n * 2048 + k * 1024); } while (0)
#define PG8_MMA(ai, bj, At, Bt) do { __builtin_amdgcn_s_setprio(1); _Pragma("unroll") for (int m = 0; m < 4; ++m) _Pragma("unroll") for (int n = 0; n < 2; ++n) _Pragma("unroll") for (int k = 0; k < 2; ++k) \
        acc[ai][bj][m][n] = __builtin_amdgcn_mfma_f32_16x16x32_bf16(Bt[n][k], At[m][k], acc[ai][bj][m][n], 0, 0, 0); __builtin_amdgcn_s_setprio(0); } while (0)
#define PG8_WAIT_V(n) asm volatile("s_waitcnt vmcnt(" #n ")" ::: "memory")
#define PG8_WAIT_L(n) asm volatile("s_waitcnt lgkmcnt(" #n ")" ::: "memory")
#define PG8_BAR __builtin_amdgcn_s_barrier()
#define PG8_SCHED __builtin_amdgcn_sched_barrier(0)
    Unit cur, nxt; int ui = 0;
    if (!S.next(0, cur)) return;
    f32x4 acc[2][2][4][2];
#pragma unroll
    for (int a = 0; a < 2; ++a)
#pragma unroll
        for (int b = 0; b < 2; ++b)
#pragma unroll
            for (int m = 0; m < 4; ++m)
#pragma unroll
                for (int n = 0; n < 2; ++n) acc[a][b][m][n] = (f32x4){0.f, 0.f, 0.f, 0.f};
    bf16x8 At[4][2], B0[2][2], B1[2][2];
    const char* cA = (const char*)g.A + (size_t)cur.pm * tstepA; const char* cB = (const char*)g.Bt + (size_t)cur.pn * tstepB;
    PG8_STAGE(PG8_SB(0, 0), cB, voffB); PG8_STAGE(PG8_SB(0, 1), cB + hstepB, voffB); PG8_STAGE(PG8_SA(0, 0), cA, voffA); PG8_STAGE(PG8_SA(0, 1), cA + hstepA, voffA);
    if (wr == 1) PG8_BAR;
    PG8_WAIT_V(2); PG8_BAR;
    PG8_STAGE(PG8_SB(1, 0), cB + kstep, voffB); PG8_STAGE(PG8_SA(1, 0), cA + kstep, voffA); PG8_STAGE(PG8_SB(1, 1), cB + hstepB + kstep, voffB);
    PG8_WAIT_V(6); PG8_BAR;
    for (;;) {
        const bool has_next = S.next(ui + 1, nxt);
        const char* nA = has_next ? (const char*)g.A + (size_t)nxt.pm * tstepA : cA; const char* nB = has_next ? (const char*)g.Bt + (size_t)nxt.pn * tstepB : cB;
        for (int t = 0; t < nt; t += 2) {
            const bool last = (t == nt - 2);
            const char* a1 = cA + (size_t)(t + 1) * kstep;
            const char* a2 = last ? nA : cA + (size_t)(t + 2) * kstep; const char* b2 = last ? nB : cB + (size_t)(t + 2) * kstep;
            const char* a3 = a2 + kstep; const char* b3 = b2 + kstep;
            PG8_LDB(B0, 0, 0); PG8_LDB(B1, 0, 1); PG8_SCHED; PG8_LDA(At, 0, 0); PG8_STAGE(PG8_SA(1, 1), a1 + hstepA, voffA);
            PG8_WAIT_V(8); PG8_WAIT_L(0); PG8_BAR; PG8_MMA(0, 0, At, B0); PG8_MMA(0, 1, At, B1); PG8_BAR; PG8_SCHED;
            PG8_LDA(At, 0, 1); PG8_STAGE(PG8_SB(0, 0), b2, voffB); PG8_STAGE(PG8_SB(0, 1), b2 + hstepB, voffB); PG8_STAGE(PG8_SA(0, 0), a2, voffA);
            PG8_WAIT_V(8); PG8_WAIT_L(0); PG8_BAR; PG8_MMA(1, 0, At, B0); PG8_MMA(1, 1, At, B1); PG8_BAR; PG8_SCHED;
            PG8_LDB(B0, 1, 0); PG8_LDB(B1, 1, 1); PG8_SCHED; PG8_LDA(At, 1, 0); PG8_STAGE(PG8_SA(0, 1), a2 + hstepA, voffA);
            PG8_WAIT_V(8); PG8_WAIT_L(0); PG8_BAR; PG8_MMA(0, 0, At, B0); PG8_MMA(0, 1, At, B1); PG8_BAR; PG8_SCHED;
            PG8_LDA(At, 1, 1); PG8_STAGE(PG8_SB(1, 0), b3, voffB); PG8_STAGE(PG8_SB(1, 1), b3 + hstepB, voffB); PG8_STAGE(PG8_SA(1, 0), a3, voffA);
            PG8_WAIT_V(8); PG8_WAIT_L(0); PG8_BAR; PG8_MMA(1, 0, At, B0); PG8_MMA(1, 1, At, B1); PG8_BAR; PG8_SCHED;
        }
        if (wr == 0) PG8_BAR;
        E(acc, cur, wr, wc, fr, fq);
        if (!has_next) break;
#pragma unroll
        for (int a = 0; a < 2; ++a)
#pragma unroll
            for (int b = 0; b < 2; ++b)
#pragma unroll
                for (int m = 0; m < 4; ++m)
#pragma unroll
                    for (int n = 0; n < 2; ++n) acc[a][b][m][n] = (f32x4){0.f, 0.f, 0.f, 0.f};
        cur = nxt; cA = nA; cB = nB; ++ui;
        if (wr == 1) PG8_BAR;
    }
    PG8_WAIT_V(0);
    PG8_BAR;
#undef PG8_SA
#undef PG8_SB
#undef PG8_STAGE
#undef PG8_LDA
#undef PG8_LDB
#undef PG8_MMA
#undef PG8_WAIT_V
#undef PG8_WAIT_L
#undef PG8_BAR
#undef PG8_SCHED
}
}

__device__ __forceinline__ void t_load(const float* W, int ldw, int src_n0, int nvalid, int k0, int lane, f32x4 (&v)[16]) {
    const int n4 = lane & 15, kr = lane >> 4;
    const float* wp = W + (size_t)(k0 + kr) * ldw + src_n0 + 4 * n4;
    const bool ok = 4 * n4 < nvalid;
#pragma unroll
    for (int i = 0; i < 16; ++i) { v[i] = (f32x4){0.f, 0.f, 0.f, 0.f}; if (ok) v[i] = __builtin_nontemporal_load((const f32x4*)(wp + (size_t)(4 * i) * ldw)); }
}
__device__ __forceinline__ void t_store(const f32x4 (&v)[16], bf16_t* WT, int K, int dst_n0, int k0, LAS float* scr, int lane) {
    const int n4 = lane & 15, kr = lane >> 4;
#pragma unroll
    for (int i = 0; i < 16; ++i) { LAS float* d = scr + (4 * i + kr) * 65 + 4 * n4; d[0] = v[i][0]; d[1] = v[i][1]; d[2] = v[i][2]; d[3] = v[i][3]; }
    LGKM0();
    const int c8 = lane & 7;
#pragma unroll
    for (int j = 0; j < 8; ++j) { const int n = (lane >> 3) + 8 * j; const LAS float* sp = scr + (8 * c8) * 65 + n;
        u32x4 o; o.x = cvt_pk_bf16(sp[0 * 65], sp[1 * 65]); o.y = cvt_pk_bf16(sp[2 * 65], sp[3 * 65]); o.z = cvt_pk_bf16(sp[4 * 65], sp[5 * 65]); o.w = cvt_pk_bf16(sp[6 * 65], sp[7 * 65]);
        *(u32x4*)(WT + (size_t)(dst_n0 + n) * K + k0 + 8 * c8) = o; }
    LGKM0();
}
__device__ __forceinline__ int in_src_col(int n) {
    if (n < 1024) return n;
    if (n < 2048) return 3584 + (n - 1024);
    if (n < 2304) return 1024 + (n - 2048);
    if (n < 2560) return 1280 + (n - 2304);
    if (n < 3072) return 1536 + (n - 2560);
    if (n < 3584) return 2048 + (n - 3072);
    if (n < 4608) return 2560 + (n - 3584);
    return n;
}
template <bool WIN>
__device__ __forceinline__ void convert_w(const float* W, int K, int N, bf16_t* WT, LAS float* scr, int lane, int gw, int NGW) {
    const int nblk = N / 64, items = (K / 64) * nblk, ldw = WIN ? INCOLS : N;
    int it = gw; if (it >= items) return;
    int k0 = 64 * (it / nblk), n0 = 64 * (it % nblk), src = n0, nvalid = 64;
    if (WIN) { src = in_src_col(n0); nvalid = INCOLS - src; nvalid = nvalid < 0 ? 0 : (nvalid > 64 ? 64 : nvalid); if (n0 < 4608) nvalid = 64; if (nvalid == 0) src = 0; }
    f32x4 v[16];
    t_load(W, ldw, src, nvalid, k0, lane, v);
    for (;;) {
        const int itn = it + NGW; const bool hn = itn < items;
        int k0n = 0, n0n = 0; f32x4 vn[16];
        if (hn) { k0n = 64 * (itn / nblk); n0n = 64 * (itn % nblk); int srcn = n0n, nvn = 64;
            if (WIN) { srcn = in_src_col(n0n); nvn = INCOLS - srcn; nvn = nvn < 0 ? 0 : (nvn > 64 ? 64 : nvn); if (n0n < 4608) nvn = 64; if (nvn == 0) srcn = 0; }
            t_load(W, ldw, srcn, nvn, k0n, lane, vn); }
        t_store(v, WT, K, n0, k0, scr, lane);
        if (!hn) break;
#pragma unroll
        for (int i = 0; i < 16; ++i) v[i] = vn[i];
        it = itn; k0 = k0n; n0 = n0n;
    }
}
__device__ __forceinline__ void convert_plain(const float* W, int K, int N, bf16_t* WT, LAS float* scr, int lane, int gw, int NGW) { convert_w<false>(W, K, N, WT, scr, lane, gw, NGW); }
__device__ __forceinline__ void convert_win(const float* W, bf16_t* WT, LAS float* scr, int lane, int gw, int NGW) { convert_w<true>(W, DM, NIN, WT, scr, lane, gw, NGW); }

__device__ __forceinline__ void row_phase(const float* xf, const bf16_t* xb, const bf16_t* y, const float* gpost, bf16_t* xob, float* xof, const float* gnext, bf16_t* hout, int lane, int gw, int NGW) {
    int m = gw; if (m >= T) return;
    f32x4 v[8]; u32x2 xw[8], yw[8];
    { if (xf) { const f32x4* xr = (const f32x4*)(xf + (size_t)m * DM) + lane;
#pragma unroll
          for (int j = 0; j < 8; ++j) v[j] = __builtin_nontemporal_load(xr + 64 * j); }
      else { const u32x2* xr = (const u32x2*)(xb + (size_t)m * DM) + lane;
#pragma unroll
          for (int j = 0; j < 8; ++j) xw[j] = __builtin_nontemporal_load(xr + 64 * j); }
      if (y) { const u32x2* yr = (const u32x2*)(y + (size_t)m * DM) + lane;
#pragma unroll
          for (int j = 0; j < 8; ++j) yw[j] = __builtin_nontemporal_load(yr + 64 * j); } }
    for (;;) {
        const int mn = m + NGW; const bool hn = mn < T;
        f32x4 vn[8]; u32x2 xwn[8], ywn[8];
        if (hn) {
            if (xf) { const f32x4* xr = (const f32x4*)(xf + (size_t)mn * DM) + lane;
#pragma unroll
                for (int j = 0; j < 8; ++j) vn[j] = __builtin_nontemporal_load(xr + 64 * j); }
            else { const u32x2* xr = (const u32x2*)(xb + (size_t)mn * DM) + lane;
#pragma unroll
                for (int j = 0; j < 8; ++j) xwn[j] = __builtin_nontemporal_load(xr + 64 * j); }
            if (y) { const u32x2* yr = (const u32x2*)(y + (size_t)mn * DM) + lane;
#pragma unroll
                for (int j = 0; j < 8; ++j) ywn[j] = __builtin_nontemporal_load(yr + 64 * j); } }
        if (!xf) {
#pragma unroll
            for (int j = 0; j < 8; ++j) v[j] = (f32x4){bflo(xw[j].x), bfhi(xw[j].x), bflo(xw[j].y), bfhi(xw[j].y)}; }
        if (y) {
            f32x4 yv[8]; float s = 0.f;
#pragma unroll
            for (int j = 0; j < 8; ++j) { const u32x2 w = yw[j]; yv[j] = (f32x4){bflo(w.x), bfhi(w.x), bflo(w.y), bfhi(w.y)};
                s += (yv[j][0] * yv[j][0] + yv[j][1] * yv[j][1]) + (yv[j][2] * yv[j][2] + yv[j][3] * yv[j][3]); }
            s = wave_sum(s);
            const float rstd = 1.0f / sqrtf(s * (1.0f / DM) + NORM_EPS);
#pragma unroll
            for (int j = 0; j < 8; ++j) { const f32x4 gg = ((const f32x4*)gpost)[lane + 64 * j]; v[j] = v[j] + yv[j] * rstd * gg; }
            if (xof) { f32x4* xo = (f32x4*)(xof + (size_t)m * DM) + lane;
#pragma unroll
                for (int j = 0; j < 8; ++j) __builtin_nontemporal_store(v[j], xo + 64 * j); }
            else { u32x2* xo = (u32x2*)(xob + (size_t)m * DM) + lane;
#pragma unroll
                for (int j = 0; j < 8; ++j) { u32x2 w; w.x = cvt_pk_bf16(v[j][0], v[j][1]); w.y = cvt_pk_bf16(v[j][2], v[j][3]); __builtin_nontemporal_store(w, xo + 64 * j); } }
        }
        if (gnext) {
            float s = 0.f;
#pragma unroll
            for (int j = 0; j < 8; ++j) s += (v[j][0] * v[j][0] + v[j][1] * v[j][1]) + (v[j][2] * v[j][2] + v[j][3] * v[j][3]);
            s = wave_sum(s);
            const float rstd = 1.0f / sqrtf(s * (1.0f / DM) + NORM_EPS);
            u32x2* ho = (u32x2*)(hout + (size_t)m * DM) + lane;
#pragma unroll
            for (int j = 0; j < 8; ++j) { const f32x4 gg = ((const f32x4*)gnext)[lane + 64 * j]; const f32x4 o = v[j] * rstd * gg;
                u32x2 w; w.x = cvt_pk_bf16(o[0], o[1]); w.y = cvt_pk_bf16(o[2], o[3]); ho[64 * j] = w; }
        }
        if (!hn) break;
#pragma unroll
        for (int j = 0; j < 8; ++j) { v[j] = vn[j]; xw[j] = xwn[j]; yw[j] = ywn[j]; }
        m = mn;
    }
}

template <int R>
__device__ __forceinline__ void row_phase_b(const bf16_t* xb, const bf16_t* y, const float* gpost, bf16_t* xob, float* xof, const float* gnext, bf16_t* hout, int lane, int gw, int NGW) {
    if (gw >= T) return;
    const int nrows = (T - gw + NGW - 1) / NGW;
    u32x2 xw[R][8], yw[R][8];
#pragma unroll
    for (int i = 0; i < R; ++i) if (i < nrows) { const size_t m = (size_t)gw + (size_t)i * NGW;
        const u32x2* xr = (const u32x2*)(xb + m * DM) + lane; const u32x2* yr = (const u32x2*)(y + m * DM) + lane;
#pragma unroll
        for (int j = 0; j < 8; ++j) { xw[i][j] = __builtin_nontemporal_load(xr + 64 * j); yw[i][j] = __builtin_nontemporal_load(yr + 64 * j); } }
    for (int k0 = 0; k0 < nrows; k0 += R) {
#pragma unroll
        for (int i = 0; i < R; ++i) { const int k = k0 + i;
            if (k < nrows) {
                const size_t m = (size_t)gw + (size_t)k * NGW;
                f32x4 v[8], yv[8]; float s = 0.f;
#pragma unroll
                for (int j = 0; j < 8; ++j) { const u32x2 a = xw[i][j], w = yw[i][j];
                    v[j] = (f32x4){bflo(a.x), bfhi(a.x), bflo(a.y), bfhi(a.y)}; yv[j] = (f32x4){bflo(w.x), bfhi(w.x), bflo(w.y), bfhi(w.y)};
                    s += (yv[j][0] * yv[j][0] + yv[j][1] * yv[j][1]) + (yv[j][2] * yv[j][2] + yv[j][3] * yv[j][3]); }
                if (k + R < nrows) { const size_t mn = (size_t)gw + (size_t)(k + R) * NGW;
                    const u32x2* xr = (const u32x2*)(xb + mn * DM) + lane; const u32x2* yr = (const u32x2*)(y + mn * DM) + lane;
#pragma unroll
                    for (int j = 0; j < 8; ++j) { xw[i][j] = __builtin_nontemporal_load(xr + 64 * j); yw[i][j] = __builtin_nontemporal_load(yr + 64 * j); } }
                s = wave_sum(s);
                const float rstd = 1.0f / sqrtf(s * (1.0f / DM) + NORM_EPS);
#pragma unroll
                for (int j = 0; j < 8; ++j) { const f32x4 gg = ((const f32x4*)gpost)[lane + 64 * j]; v[j] = v[j] + yv[j] * rstd * gg; }
                if (xof) { f32x4* xo = (f32x4*)(xof + m * DM) + lane;
#pragma unroll
                    for (int j = 0; j < 8; ++j) __builtin_nontemporal_store(v[j], xo + 64 * j); }
                else { u32x2* xo = (u32x2*)(xob + m * DM) + lane;
#pragma unroll
                    for (int j = 0; j < 8; ++j) { u32x2 w; w.x = cvt_pk_bf16(v[j][0], v[j][1]); w.y = cvt_pk_bf16(v[j][2], v[j][3]); __builtin_nontemporal_store(w, xo + 64 * j); } }
                if (gnext) {
                    float s2 = 0.f;
#pragma unroll
                    for (int j = 0; j < 8; ++j) s2 += (v[j][0] * v[j][0] + v[j][1] * v[j][1]) + (v[j][2] * v[j][2] + v[j][3] * v[j][3]);
                    s2 = wave_sum(s2);
                    const float rstd2 = 1.0f / sqrtf(s2 * (1.0f / DM) + NORM_EPS);
                    u32x2* ho = (u32x2*)(hout + m * DM) + lane;
#pragma unroll
                    for (int j = 0; j < 8; ++j) { const f32x4 gg = ((const f32x4*)gnext)[lane + 64 * j]; const f32x4 o = v[j] * rstd2 * gg;
                        u32x2 w; w.x = cvt_pk_bf16(o[0], o[1]); w.y = cvt_pk_bf16(o[2], o[3]); ho[64 * j] = w; }
                }
            }
        }
    }
}

__device__ __forceinline__ void prep_phase(bf16_t* proj, const float* convw, bf16_t* qc, bf16_t* kc, int lane, int gw, int NGW) {
    if (gw >= T) return;
    constexpr int R = 4;
    const int nrows = (T - gw + NGW - 1) / NGW;
    const float invf = exp2f(-(float)lane * (13.287712379549449f / 64.0f));
    float cw[2][3][8];
#pragma unroll
    for (int jj = 0; jj < 2; ++jj)
#pragma unroll
        for (int tp = 0; tp < 3; ++tp) { const f32x4 w0 = *(const f32x4*)(convw + tp * 1024 + lane * 8 + 512 * jj), w1 = *(const f32x4*)(convw + tp * 1024 + lane * 8 + 512 * jj + 4);
            cw[jj][tp][0] = w0[0]; cw[jj][tp][1] = w0[1]; cw[jj][tp][2] = w0[2]; cw[jj][tp][3] = w0[3]; cw[jj][tp][4] = w1[0]; cw[jj][tp][5] = w1[1]; cw[jj][tp][6] = w1[2]; cw[jj][tp][7] = w1[3]; }
    u32x4 cur[R][2], prv[R][2], nxt[R][2]; bf16_t kx[R][4];
#define PREP_LOAD(slot, mrow) do { const size_t _m = (mrow); const int _pos = (int)(_m & (SEQ - 1)); const bf16_t* _pr = proj + _m * NPROJ; \
        _Pragma("unroll") for (int jj = 0; jj < 2; ++jj) { const int _ch = lane * 8 + 512 * jj; cur[slot][jj] = *(const u32x4*)(_pr + PC_MQ + _ch); \
            prv[slot][jj] = (u32x4){0u, 0u, 0u, 0u}; nxt[slot][jj] = (u32x4){0u, 0u, 0u, 0u}; \
            if (_pos > 0) prv[slot][jj] = *(const u32x4*)(_pr - NPROJ + PC_MQ + _ch); \
            if (_pos < SEQ - 1) nxt[slot][jj] = *(const u32x4*)(_pr + NPROJ + PC_MQ + _ch); } \
        kx[slot][0] = _pr[PC_AK + lane]; kx[slot][1] = _pr[PC_AK + 64 + lane]; kx[slot][2] = _pr[PC_AK + 128 + lane]; kx[slot][3] = _pr[PC_AK + 192 + lane]; } while (0)
#pragma unroll
    for (int i = 0; i < R; ++i) if (i < nrows) PREP_LOAD(i, (size_t)gw + (size_t)i * NGW);
    for (int k0 = 0; k0 < nrows; k0 += R) {
#pragma unroll
        for (int i = 0; i < R; ++i) { const int k = k0 + i;
            if (k < nrows) {
                const size_t m = (size_t)gw + (size_t)k * NGW;
                u32x4 c2[2], p2[2], n2[2]; bf16_t k4[4];
#pragma unroll
                for (int jj = 0; jj < 2; ++jj) { c2[jj] = cur[i][jj]; p2[jj] = prv[i][jj]; n2[jj] = nxt[i][jj]; }
#pragma unroll
                for (int q = 0; q < 4; ++q) k4[q] = kx[i][q];
                if (k + R < nrows) PREP_LOAD(i, (size_t)gw + (size_t)(k + R) * NGW);
                const int pos = (int)(m & (SEQ - 1));
                const float ang = (float)pos * invf;
                const double rev = (double)ang * 0.15915494309189535; const float f = (float)(rev - rint(rev));
                const float sn = __builtin_amdgcn_sinf(f), cs = __builtin_amdgcn_cosf(f);
                bf16_t* pr = proj + m * NPROJ;
#pragma unroll
                for (int hh = 0; hh < 2; ++hh) { const int base = PC_AK + hh * 128;
                    const float x1 = bf2f(k4[2 * hh]), x2 = bf2f(k4[2 * hh + 1]);
                    pr[base + lane] = f2bf(x1 * cs - x2 * sn); pr[base + 64 + lane] = f2bf(x2 * cs + x1 * sn); }
#pragma unroll
                for (int jj = 0; jj < 2; ++jj) { float yv[8];
#pragma unroll
                    for (int e = 0; e < 4; ++e) {
                        const float ya = cw[jj][0][2 * e] * bflo(p2[jj][e]) + cw[jj][1][2 * e] * bflo(c2[jj][e]) + cw[jj][2][2 * e] * bflo(n2[jj][e]);
                        const float yb = cw[jj][0][2 * e + 1] * bfhi(p2[jj][e]) + cw[jj][1][2 * e + 1] * bfhi(c2[jj][e]) + cw[jj][2][2 * e + 1] * bfhi(n2[jj][e]);
                        yv[2 * e] = ya * sigmoidf_(ya); yv[2 * e + 1] = yb * sigmoidf_(yb); }
                    if (jj == 0) {
#pragma unroll
                        for (int e = 0; e < 8; ++e) yv[e] *= 0.08838834764831845f; }
                    u32x4 o; o.x = cvt_pk_bf16(yv[0], yv[1]); o.y = cvt_pk_bf16(yv[2], yv[3]); o.z = cvt_pk_bf16(yv[4], yv[5]); o.w = cvt_pk_bf16(yv[6], yv[7]);
                    *(u32x4*)((jj == 0 ? qc : kc) + m * 512 + lane * 8) = o; }
            }
        }
    }
#undef PREP_LOAD
}

__device__ __forceinline__ void stage_nat128(const bf16_t* src, long ld, int nrows, int lo, int hi, LAS bf16_t* dst, int tid) {
    for (int idx = tid; idx < nrows * 16; idx += 512) { const int row = idx >> 4, c8 = idx & 15; u32x4 v = (u32x4){0u, 0u, 0u, 0u};
        if (row >= lo && row < hi) v = *(const u32x4*)(src + (long)row * ld + c8 * 8);
        *(LAS u32x4*)(dst + row * 136 + c8 * 8) = v; }
}
__device__ __forceinline__ void stage_T(const bf16_t* src, long ld, int nrows, int ncols, int lo, int hi, LAS bf16_t* dst, int VS, const LAS float* rowscale, int tid) {
    const int nrb = nrows >> 5, total = nrows * (ncols >> 3);
    for (int idx = tid; idx < total; idx += 512) {
        const int rlo = idx & 31, cl = (idx >> 5) & 1, rest = idx >> 6, rowblk = rest % nrb, cp = rest / nrb;
        const int row = rowblk * 32 + rlo, chunk = 2 * cp + cl;
        u32x4 v = (u32x4){0u, 0u, 0u, 0u};
        if (row >= lo && row < hi) v = *(const u32x4*)(src + (long)row * ld + chunk * 8);
        LAS bf16_t* d = dst + (chunk * 8) * VS + row;
        if (rowscale) { const float sc = rowscale[row];
#pragma unroll
            for (int e = 0; e < 4; ++e) { const unsigned w = cvt_pk_bf16(bflo(v[e]) * sc, bfhi(v[e]) * sc); d[(2 * e) * VS] = (bf16_t)(w & 0xffffu); d[(2 * e + 1) * VS] = (bf16_t)(w >> 16); }
        } else {
#pragma unroll
            for (int e = 0; e < 4; ++e) { d[(2 * e) * VS] = (bf16_t)(v[e] & 0xffffu); d[(2 * e + 1) * VS] = (bf16_t)(v[e] >> 16); }
        }
    }
}
__device__ __forceinline__ bf16x8 ld_pair(const LAS bf16_t* p0, const LAS bf16_t* p1) {
    const bf16x4 lo = *(const LAS bf16x4*)p0, hi = *(const LAS bf16x4*)p1;
    return __builtin_shufflevector(lo, hi, 0, 1, 2, 3, 4, 5, 6, 7);
}
__device__ __forceinline__ bf16x8 pack8(const f32x4 a, const f32x4 b) {
    u32x4 w; w.x = cvt_pk_bf16(a[0], a[1]); w.y = cvt_pk_bf16(a[2], a[3]); w.z = cvt_pk_bf16(b[0], b[1]); w.w = cvt_pk_bf16(b[2], b[3]);
    return (bf16x8)w;
}

template <int N> __device__ __forceinline__ void ld_nat(const bf16_t* src, long ld, int lo, int hi, int tid, u32x4 (&v)[N]) {
#pragma unroll
    for (int i = 0; i < N; ++i) { const int idx = tid + 512 * i, row = idx >> 4, c8 = idx & 15; v[i] = (u32x4){0u, 0u, 0u, 0u};
        if (row >= lo && row < hi) v[i] = *(const u32x4*)(src + (long)row * ld + c8 * 8); }
}
template <int N> __device__ __forceinline__ void st_nat(const u32x4 (&v)[N], LAS bf16_t* dst, int tid) {
    asm volatile("" : "+v"(tid));
#pragma unroll
    for (int i = 0; i < N; ++i) { const int idx = tid + 512 * i, row = idx >> 4, c8 = idx & 15; *(LAS u32x4*)(dst + row * 136 + c8 * 8) = v[i]; }
}
template <int N, int NROWS> __device__ __forceinline__ void ld_T(const bf16_t* src, long ld, int lo, int hi, int tid, u32x4 (&v)[N]) {
    constexpr int nrb = NROWS >> 5;
#pragma unroll
    for (int i = 0; i < N; ++i) { const int idx = tid + 512 * i, rlo = idx & 31, cl = (idx >> 5) & 1, rest = idx >> 6, rowblk = rest % nrb, cp = rest / nrb;
        const int row = rowblk * 32 + rlo, chunk = 2 * cp + cl; v[i] = (u32x4){0u, 0u, 0u, 0u};
        if (row >= lo && row < hi) v[i] = *(const u32x4*)(src + (long)row * ld + chunk * 8); }
}
template <int N, int NROWS> __device__ __forceinline__ void st_T(const u32x4 (&v)[N], LAS bf16_t* dst, int VS, const LAS float* rowscale, int tid) {
    constexpr int nrb = NROWS >> 5;
    asm volatile("" : "+v"(tid));
#pragma unroll
    for (int i = 0; i < N; ++i) { const int idx = tid + 512 * i, rlo = idx & 31, cl = (idx >> 5) & 1, rest = idx >> 6, rowblk = rest % nrb, cp = rest / nrb;
        const int row = rowblk * 32 + rlo, chunk = 2 * cp + cl;
        LAS bf16_t* d = dst + (chunk * 8) * VS + row;
        if (rowscale) { const float sc = rowscale[row];
#pragma unroll
            for (int e = 0; e < 4; ++e) { const unsigned w = cvt_pk_bf16(bflo(v[i][e]) * sc, bfhi(v[i][e]) * sc); d[(2 * e) * VS] = (bf16_t)(w & 0xffffu); d[(2 * e + 1) * VS] = (bf16_t)(w >> 16); }
        } else {
#pragma unroll
            for (int e = 0; e < 4; ++e) { d[(2 * e) * VS] = (bf16_t)(v[i][e] & 0xffffu); d[(2 * e + 1) * VS] = (bf16_t)(v[i][e] >> 16); }
        } }
}

__device__ __forceinline__ void attn_item(int item, bf16_t* proj, const float* sink, LAS unsigned char* lds, int tid) {
    const int j = item & 63, qh = (item >> 6) & 7, b = item >> 9, kvh = qh >> 2;
    const int wave = tid >> 6, lane = tid & 63, r = lane & 15, fq = lane >> 4;
    LAS bf16_t* Ks = (LAS bf16_t*)lds;
    LAS bf16_t* Vt = (LAS bf16_t*)lds;
    const int kpos0 = j * 128 - 128;
    const int lo = kpos0 < 0 ? -kpos0 : 0, hi = (kpos0 + 384 > SEQ) ? SEQ - kpos0 : 384;
    const bf16_t* kbase = proj + ((long)b * SEQ + kpos0) * NPROJ + PC_AK + kvh * 128;
    const bf16_t* vbase = proj + ((long)b * SEQ + kpos0) * NPROJ + PC_AV + kvh * 128;
    LDS_BAR();
    stage_nat128(kbase, NPROJ, 384, lo, hi, Ks, tid);
    bf16_t* qrow = proj + ((size_t)b * SEQ + j * 128 + wave * 16 + r) * NPROJ + PC_AQ + qh * 128;
    bf16x8 qf[4];
#pragma unroll
    for (int ks = 0; ks < 4; ++ks) qf[ks] = *(const bf16x8*)(qrow + ks * 32 + fq * 8);
    {
        const float posf = (float)(j * 128 + wave * 16 + r);
#pragma unroll
        for (int k2 = 0; k2 < 2; ++k2) { const u32x4 xa = (u32x4)qf[k2], xb = (u32x4)qf[k2 + 2]; float y1[8], y2[8];
#pragma unroll
            for (int e = 0; e < 8; ++e) { const float invf = exp2f(-(float)(k2 * 32 + fq * 8 + e) * (13.287712379549449f / 64.0f));
                const float ang = posf * invf; const double rev = (double)ang * 0.15915494309189535; const float fr = (float)(rev - rint(rev));
                const float sn = __builtin_amdgcn_sinf(fr), cs = __builtin_amdgcn_cosf(fr);
                const float x1 = (e & 1) ? bfhi(xa[e >> 1]) : bflo(xa[e >> 1]), x2 = (e & 1) ? bfhi(xb[e >> 1]) : bflo(xb[e >> 1]);
                y1[e] = x1 * cs - x2 * sn; y2[e] = x2 * cs + x1 * sn; }
            u32x4 oa, ob;
#pragma unroll
            for (int e = 0; e < 4; ++e) { oa[e] = cvt_pk_bf16(y1[2 * e], y1[2 * e + 1]); ob[e] = cvt_pk_bf16(y2[2 * e], y2[2 * e + 1]); }
            qf[k2] = (bf16x8)oa; qf[k2 + 2] = (bf16x8)ob; } }
    LDS_BAR();
    const int w = __builtin_amdgcn_readfirstlane(wave);
    const bool jf = (j != 0), jl = (j != 63);
#define ATT_TV(st) ((st) < 8 ? ((st) >= w && jf) : ((st) < 16 ? true : (((st) - 16) <= w && jl)))
    f32x4 sacc[24];
#pragma unroll
    for (int st = 0; st < 24; ++st) { f32x4 a4 = (f32x4){0.f, 0.f, 0.f, 0.f};
        if (ATT_TV(st)) {
#pragma unroll
            for (int ks = 0; ks < 4; ++ks) { const bf16x8 a = *(const LAS bf16x8*)(Ks + (16 * st + r) * 136 + ks * 32 + fq * 8); a4 = MFMA16(a, qf[ks], a4); } }
        sacc[st] = a4; }
    const float cs2 = 0.08838834764831845f * 1.4426950408889634f;
    const float snk2 = sink[qh] * 1.4426950408889634f;
    float mx = -3.0e38f;
#pragma unroll
    for (int st = 0; st < 24; ++st) {
        if (ATT_TV(st)) {
#pragma unroll
            for (int jj = 0; jj < 4; ++jj) { float sv = sacc[st][jj];
                if (st < 8) { if (st == w) sv = (4 * fq + jj >= r) ? sv : -3.0e38f; }
                else if (st >= 16) { if (st - 16 == w) sv = (4 * fq + jj <= r) ? sv : -3.0e38f; }
                sacc[st][jj] = sv; mx = fmaxf(mx, sv); } } }
    mx = fmaxf(mx, __shfl_xor(mx, 16)); mx = fmaxf(mx, __shfl_xor(mx, 32));
    const float m2 = fmaxf(mx * cs2, snk2);
    float sum = 0.f;
#pragma unroll
    for (int st = 0; st < 24; ++st) {
        if (ATT_TV(st)) {
#pragma unroll
            for (int jj = 0; jj < 4; ++jj) { const float p = __builtin_amdgcn_exp2f(fmaf(sacc[st][jj], cs2, -m2)); sacc[st][jj] = p; sum += p; } }
        else sacc[st] = (f32x4){0.f, 0.f, 0.f, 0.f}; }
    sum += __shfl_xor(sum, 16); sum += __shfl_xor(sum, 32);
    const float inv = 1.0f / (sum + __builtin_amdgcn_exp2f(snk2 - m2));
    bf16x8 pb[12];
#pragma unroll
    for (int kp = 0; kp < 12; ++kp) pb[kp] = pack8(sacc[2 * kp], sacc[2 * kp + 1]);
    LDS_BAR();
    stage_T(vbase, NPROJ, 384, 128, lo, hi, Vt, 396, nullptr, tid);
    LDS_BAR();
    f32x4 o[8];
#pragma unroll
    for (int dt = 0; dt < 8; ++dt) o[dt] = (f32x4){0.f, 0.f, 0.f, 0.f};
#pragma unroll
    for (int kp = 0; kp < 12; ++kp) {
        if (ATT_TV(2 * kp) || ATT_TV(2 * kp + 1)) {
            const LAS bf16_t* vr = Vt + r * 396 + 4 * fq + kp * 32;
#pragma unroll
            for (int dt = 0; dt < 8; ++dt) { const bf16x8 a = ld_pair(vr + dt * (16 * 396), vr + dt * (16 * 396) + 16); o[dt] = MFMA16(a, pb[kp], o[dt]); } } }
#pragma unroll
    for (int dt = 0; dt < 8; ++dt) { u32x2 wv; wv.x = cvt_pk_bf16(o[dt][0] * inv, o[dt][1] * inv); wv.y = cvt_pk_bf16(o[dt][2] * inv, o[dt][3] * inv);
        *(u32x2*)(qrow + 16 * dt + 4 * fq) = wv; }
#undef ATT_TV
}

__device__ __forceinline__ void mlstm_local_item(int item, const bf16_t* proj, const bf16_t* kc, const float* gates, const float* gbias, bf16_t* Cb, float* nb, float* mloc, float* gch,
                                                 LAS unsigned char* lds, int tid) {
    asm volatile("" : "+v"(tid));
    const int c = item & 63, h = (item >> 6) & 3, b = item >> 8;
    const int wave = tid >> 6, lane = tid & 63, r = lane & 15, fq = lane >> 4;
    const long row0 = (long)b * SEQ + c * 128;
    const int bh = b * 4 + h;
    LAS bf16_t* Kt = (LAS bf16_t*)lds;
    LAS bf16_t* Vt = (LAS bf16_t*)(lds + 33792);
    LAS float* lf = (LAS float*)(lds + 101376);
    LAS float* li = lf + 256; LAS float* aa = lf + 512; LAS float* we = lf + 768;
    u32x4 vreg[8], kreg[4]; float gi = 0.f, gf = 0.f;
    ld_T<8, 128>(proj + row0 * NPROJ + PC_MV + h * 256, NPROJ, 0, 128, tid, vreg);
    ld_T<4, 128>(kc + row0 * 512 + h * 128, 512, 0, 128, tid, kreg);
    if (tid < 256) { const int dir = tid >> 7, l = tid & 127;
        gi = gates[(row0 + l) * 16 + (2 * dir) * 4 + h] + gbias[(2 * dir) * 4 + h];
        gf = gates[(row0 + l) * 16 + (2 * dir + 1) * 4 + h] + gbias[(2 * dir + 1) * 4 + h]; }
    LDS_BAR();
    if (tid < 256) { li[tid] = gi; lf[tid] = logsigmoid_(gf); }
    st_T<8, 128>(vreg, Vt, 132, nullptr, tid);
    LDS_BAR();
    if (tid < 256) { const int dir = tid >> 7, l = tid & 127; float acc = 0.f, tot = 0.f;
        for (int q = 0; q < 128; ++q) { const float v = lf[dir * 128 + q]; tot += v; acc += (q <= l) ? v : 0.f; }
        if (dir) acc = tot - acc + lf[dir * 128 + l];
        aa[tid] = tot - acc + li[tid];
        if (l == 0) gch[(bh * 2 + dir) * 64 + c] = tot; }
    LDS_BAR();
    if (tid < 256) { const int dir = tid >> 7, l = tid & 127; float mxx = -3.0e38f;
        for (int q = 0; q < 128; ++q) mxx = fmaxf(mxx, aa[dir * 128 + q]);
        we[tid] = expf(aa[tid] - mxx);
        if (l == 0) mloc[(bh * 2 + dir) * 64 + c] = mxx; }
    bf16x8 bfr[2][4];
#pragma unroll
    for (int dd = 0; dd < 2; ++dd)
#pragma unroll
        for (int ks = 0; ks < 4; ++ks) { const LAS bf16_t* p = Vt + ((2 * wave + dd) * 16 + r) * 132 + ks * 32 + fq * 8; bfr[dd][ks] = ld_pair(p, p + 4); }
#pragma unroll 1
    for (int dir = 0; dir < 2; ++dir) {
        const int si = (bh * 2 + dir) * 64 + c;
        LDS_BAR();
        st_T<4, 128>(kreg, Kt, 132, we + dir * 128, tid);
        LDS_BAR();
        if (tid < 128) { float sn = 0.f; const LAS bf16_t* kr = Kt + tid * 132;
            for (int q = 0; q < 128; q += 4) { const u32x2 wv = *(const LAS u32x2*)(kr + q); sn += (bflo(wv.x) + bfhi(wv.x)) + (bflo(wv.y) + bfhi(wv.y)); }
            nb[(size_t)si * 128 + tid] = sn; }
        bf16_t* Cg = Cb + (size_t)si * 256 * 128;
#pragma unroll
        for (int dkt = 0; dkt < 8; ++dkt) { f32x4 a0 = (f32x4){0.f, 0.f, 0.f, 0.f}, a1 = (f32x4){0.f, 0.f, 0.f, 0.f};
#pragma unroll
            for (int ks = 0; ks < 4; ++ks) { const LAS bf16_t* p = Kt + (dkt * 16 + r) * 132 + ks * 32 + fq * 8; const bf16x8 a = ld_pair(p, p + 4);
                a0 = MFMA16(a, bfr[0][ks], a0); a1 = MFMA16(a, bfr[1][ks], a1); }
            u32x2 w0; w0.x = cvt_pk_bf16(a0[0], a0[1]); w0.y = cvt_pk_bf16(a0[2], a0[3]);
            u32x2 w1; w1.x = cvt_pk_bf16(a1[0], a1[1]); w1.y = cvt_pk_bf16(a1[2], a1[3]);
            *(u32x2*)(Cg + (size_t)((2 * wave) * 16 + r) * 128 + dkt * 16 + 4 * fq) = w0;
            *(u32x2*)(Cg + (size_t)((2 * wave + 1) * 16 + r) * 128 + dkt * 16 + 4 * fq) = w1; }
    }
}

__device__ __forceinline__ void mlstm_scan(bf16_t* Cb, float* nb, const float* mloc, const float* gch, float* mprev, int tid) {
    for (int vb = blockIdx.x; vb < 256; vb += gridDim.x) {
        const int bhd = vb >> 4, part = vb & 15, dir = bhd & 1;
        bf16_t* Cp = Cb + (size_t)bhd * 64 * 32768 + (size_t)(part * 512 + tid) * 4;
        const bool do_n = (part == 0) && (tid < 128);
        float* np = nb + (size_t)bhd * 64 * 128 + (tid & 127);
        float c0 = 0.f, c1 = 0.f, c2 = 0.f, c3 = 0.f, cn = 0.f, m = -1.0e30f;
        for (int s0 = 0; s0 < 64; s0 += 8) {
            u32x2 v[8]; float gg[8], ml[8], nv[8];
#pragma unroll
            for (int q = 0; q < 8; ++q) { const int c = dir ? 63 - (s0 + q) : (s0 + q);
                v[q] = *(const u32x2*)(Cp + (size_t)c * 32768); gg[q] = gch[bhd * 64 + c]; ml[q] = mloc[bhd * 64 + c]; nv[q] = do_n ? np[c * 128] : 0.f; }
#pragma unroll
            for (int q = 0; q < 8; ++q) { const int c = dir ? 63 - (s0 + q) : (s0 + q);
                u32x2 o; o.x = cvt_pk_bf16(c0, c1); o.y = cvt_pk_bf16(c2, c3);
                *(u32x2*)(Cp + (size_t)c * 32768) = o;
                if (do_n) np[c * 128] = cn;
                if (part == 0 && tid == 0) mprev[bhd * 64 + c] = m;
                const float mn = fmaxf(gg[q] + m, ml[q]);
                const float sp = expf(gg[q] + m - mn), sl = expf(ml[q] - mn);
                c0 = sp * c0 + sl * bflo(v[q].x); c1 = sp * c1 + sl * bfhi(v[q].x); c2 = sp * c2 + sl * bflo(v[q].y); c3 = sp * c3 + sl * bfhi(v[q].y);
                cn = sp * cn + sl * nv[q];
                m = mn; }
        }
    }
}

__device__ __forceinline__ void mlstm_out_item(int item, bf16_t* proj, const bf16_t* qc, const bf16_t* kc, const float* gates, const float* gbias, const bf16_t* Cb, const float* nb,
                                               const float* mprev, const float* gnorm, LAS unsigned char* lds, int tid) {
    asm volatile("" : "+v"(tid));
    const int c = item & 63, h = (item >> 6) & 3, b = item >> 8;
    const int wave = tid >> 6, lane = tid & 63, r = lane & 15, fq = lane >> 4;
    const long row0 = (long)b * SEQ + c * 128;
    const int bh = b * 4 + h;
    LAS bf16_t* Ks = (LAS bf16_t*)lds;
    LAS bf16_t* Vt = (LAS bf16_t*)(lds + 34816);
    LAS float* fl = (LAS float*)(lds + 104448);
    LAS float* lf = fl; LAS float* li = fl + 256; LAS float* bb = fl + 512; LAS float* ee = fl + 768; LAS float* Mt = fl + 1024; LAS float* mpl = fl + 1280; LAS float* npv = fl + 1536;
    const int t = 16 * wave + r;
    float mpv = 0.f;
    { u32x4 kreg[4], vreg[8]; float gi = 0.f, gf = 0.f, nn = 0.f;
      ld_nat<4>(kc + row0 * 512 + h * 128, 512, 0, 128, tid, kreg);
      ld_T<8, 128>(proj + row0 * NPROJ + PC_MV + h * 256, NPROJ, 0, 128, tid, vreg);
      if (tid < 256) { const int dir = tid >> 7, l = tid & 127; const int si = (bh * 2 + dir) * 64 + c;
          gi = gates[(row0 + l) * 16 + (2 * dir) * 4 + h] + gbias[(2 * dir) * 4 + h];
          gf = gates[(row0 + l) * 16 + (2 * dir + 1) * 4 + h] + gbias[(2 * dir + 1) * 4 + h];
          nn = nb[(size_t)si * 128 + l]; mpv = mprev[si]; }
      LDS_BAR();
      if (tid < 256) { li[tid] = gi; lf[tid] = logsigmoid_(gf); npv[tid] = nn; }
      st_nat<4>(kreg, Ks, tid);
      st_T<8, 128>(vreg, Vt, 136, nullptr, tid); }
    LDS_BAR();
    if (tid < 256) { const int dir = tid >> 7, l = tid & 127; float acc = 0.f, tot = 0.f;
        for (int q = 0; q < 128; ++q) { const float v = lf[dir * 128 + q]; tot += v; acc += (q <= l) ? v : 0.f; }
        if (dir) acc = tot - acc + lf[dir * 128 + l];
        bb[tid] = acc; ee[tid] = li[tid] - acc; }
    LDS_BAR();
    if (tid < 256) { const int dir = tid >> 7, l = tid & 127; float pmf = -3.0e38f, pmb = -3.0e38f;
        for (int q = 0; q < 128; ++q) { const float v = ee[dir * 128 + q]; pmf = fmaxf(pmf, (q <= l) ? v : -3.0e38f); pmb = fmaxf(pmb, (q >= l) ? v : -3.0e38f); }
        Mt[tid] = fmaxf(mpv, dir ? pmb : pmf);
        if (l == 0) mpl[dir] = mpv; }
    LDS_BAR();
    bf16x8 qf[4];
    { const bf16_t* qr = qc + (row0 + t) * 512 + h * 128;
#pragma unroll
      for (int ks = 0; ks < 4; ++ks) qf[ks] = *(const bf16x8*)(qr + ks * 32 + fq * 8); }
    f32x4 sacc[8];
#pragma unroll
    for (int st = 0; st < 8; ++st) { f32x4 a4 = (f32x4){0.f, 0.f, 0.f, 0.f};
#pragma unroll
        for (int ks = 0; ks < 4; ++ks) { const bf16x8 a = *(const LAS bf16x8*)(Ks + (16 * st + r) * 136 + ks * 32 + fq * 8); a4 = MFMA16(a, qf[ks], a4); }
        sacc[st] = a4; }
    LDS_BAR();
    LAS bf16_t* hsl = (LAS bf16_t*)(wave < 4 ? lds + wave * 8320 : lds + 111616 + (wave - 4) * 8320) + r * 260 + 4 * fq;
    bf16x8 pb[2][4]; float inv[2], wi[2];
    const int w = __builtin_amdgcn_readfirstlane(wave);
    const float L2E = 1.4426950408889634f;
#pragma unroll
    for (int dir = 0; dir < 2; ++dir) {
        const float Mv = Mt[dir * 128 + t]; const float mp = mpl[dir];
        const float winter = __builtin_amdgcn_exp2f((mp - Mv) * L2E);
        float qd = 0.f;
#pragma unroll
        for (int ks = 0; ks < 4; ++ks) { const LAS float* np = npv + dir * 128 + ks * 32 + fq * 8; const u32x4 qw = (u32x4)qf[ks];
            qd += bflo(qw.x) * np[0] + bfhi(qw.x) * np[1] + bflo(qw.y) * np[2] + bfhi(qw.y) * np[3] + bflo(qw.z) * np[4] + bfhi(qw.z) * np[5] + bflo(qw.w) * np[6] + bfhi(qw.w) * np[7]; }
        qd += __shfl_xor(qd, 16); qd += __shfl_xor(qd, 32);
        float den = 0.f; f32x4 pv[8];
#pragma unroll
        for (int st = 0; st < 8; ++st)
#pragma unroll
            for (int jj = 0; jj < 4; ++jj) { const int sidx = 16 * st + 4 * fq + jj; const bool valid = dir ? (sidx >= t) : (sidx <= t);
                const float wgt = valid ? __builtin_amdgcn_exp2f((ee[dir * 128 + sidx] - Mv) * L2E) : 0.f; const float p = sacc[st][jj] * wgt; den += p; pv[st][jj] = p; }
#pragma unroll
        for (int kp = 0; kp < 4; ++kp) pb[dir][kp] = pack8(pv[2 * kp], pv[2 * kp + 1]);
        den += __shfl_xor(den, 16); den += __shfl_xor(den, 32);
        const float dent = den + winter * qd;
        const float denom = fmaxf(fabsf(dent), expf(-(bb[dir * 128 + t] + Mv)));
        inv[dir] = 1.0f / denom; wi[dir] = winter;
    }
    float ss = 0.f;
    bf16_t* orow = proj + (size_t)(row0 + t) * NPROJ + PC_MO + h * 256;
    LAS bf16_t* SL = (LAS bf16_t*)(lds + 144896);
    const int srow = (tid >> 4) & 31, sc8 = tid & 15;
    const bf16_t* sg0 = Cb + (size_t)((bh * 2 + 0) * 64 + c) * 32768 + srow * 128 + sc8 * 8;
    const bf16_t* sg1 = Cb + (size_t)((bh * 2 + 1) * 64 + c) * 32768 + srow * 128 + sc8 * 8;
    LAS bf16_t* sdst = SL + srow * 136 + sc8 * 8;
    u32x4 pre0 = *(const u32x4*)sg0, pre1 = *(const u32x4*)sg1;
#pragma unroll 1
    for (int sl = 0; sl < 8; ++sl) {
        LDS_BAR();
        *(LAS u32x4*)sdst = pre0; *(LAS u32x4*)(sdst + 32 * 136) = pre1;
        LDS_BAR();
        { const int sn = sl < 7 ? sl + 1 : 7; pre0 = *(const u32x4*)(sg0 + (size_t)sn * 4096); pre1 = *(const u32x4*)(sg1 + (size_t)sn * 4096); }
#pragma unroll
        for (int d2 = 0; d2 < 2; ++d2) {
            const int dvt = sl * 2 + d2;
            f32x4 hsum = (f32x4){0.f, 0.f, 0.f, 0.f};
            const LAS bf16_t* vr = Vt + (dvt * 16 + r) * 136 + 4 * fq;
#pragma unroll
            for (int dir = 0; dir < 2; ++dir) {
                f32x4 a4 = (f32x4){0.f, 0.f, 0.f, 0.f};
                const LAS bf16_t* cr = SL + dir * (32 * 136) + (d2 * 16 + r) * 136 + fq * 8;
#pragma unroll
                for (int ks = 0; ks < 4; ++ks) { const bf16x8 a = *(const LAS bf16x8*)(cr + ks * 32); a4 = MFMA16(a, qf[ks], a4); }
                a4 = a4 * wi[dir];
#pragma unroll
                for (int kp = 0; kp < 4; ++kp) { const bf16x8 a = ld_pair(vr + kp * 32, vr + kp * 32 + 16); a4 = MFMA16(a, pb[dir][kp], a4); }
                hsum = hsum + a4 * inv[dir];
            }
            ss += (hsum[0] * hsum[0] + hsum[1] * hsum[1]) + (hsum[2] * hsum[2] + hsum[3] * hsum[3]);
            u32x2 w; w.x = cvt_pk_bf16(hsum[0], hsum[1]); w.y = cvt_pk_bf16(hsum[2], hsum[3]);
            *(LAS u32x2*)(hsl + dvt * 16) = w;
        }
    }
    ss += __shfl_xor(ss, 16); ss += __shfl_xor(ss, 32);
    const float rn = 1.0f / sqrtf(ss * (1.0f / 256.0f) + NORM_EPS);
#pragma unroll 8
    for (int dvt = 0; dvt < 16; ++dvt) { const int dv0 = dvt * 16 + 4 * fq;
        const f32x4 gg = *(const f32x4*)(gnorm + h * 256 + dv0);
        const u32x2 mo = *(const u32x2*)(orow + dv0);
        const u32x2 v = *(const LAS u32x2*)(hsl + dvt * 16);
        const float o0 = bflo(v.x) * rn * gg[0] * sigmoidf_(bflo(mo.x)), o1 = bfhi(v.x) * rn * gg[1] * sigmoidf_(bfhi(mo.x));
        const float o2 = bflo(v.y) * rn * gg[2] * sigmoidf_(bflo(mo.y)), o3 = bfhi(v.y) * rn * gg[3] * sigmoidf_(bfhi(mo.y));
        u32x2 w; w.x = cvt_pk_bf16(o0, o1); w.y = cvt_pk_bf16(o2, o3);
        *(u32x2*)(orow + dv0) = w; }
}


#define XB_TMO      128
#define XB_XCNT(j)  (256  + 64 * (j))
#define XB_XSUB(j)  (1280 + 64 * (j))
#define XB_XGEN(j)  (2304 + 64 * (j))
#define XB_TOP      3328
#define XB_TOPGEN   3392
#define XCD_BAR_WORDS 3456
#define XB_SPIN_CAP (1u << 20)
__device__ __forceinline__ unsigned xb_ld(unsigned* p)              { return __hip_atomic_load(p, __ATOMIC_RELAXED, __HIP_MEMORY_SCOPE_AGENT); }
__device__ __forceinline__ unsigned xb_add(unsigned* p, unsigned v) { return __hip_atomic_fetch_add(p, v, __ATOMIC_RELAXED, __HIP_MEMORY_SCOPE_AGENT); }
__device__ __forceinline__ unsigned xb_xcc_id() { return (unsigned)__builtin_amdgcn_s_getreg((3 << 11) | 20) & 0xFu; }
#define XB_SPIN(cond, bar) do { unsigned _sp = 0; while (cond) { __builtin_amdgcn_s_sleep(1); \
    if ((++_sp & 255u) == 0u) { if (xb_ld(&(bar)[XB_TMO])) break; if (_sp > XB_SPIN_CAP) { atomicAdd(&(bar)[XB_TMO], 1u); break; } } } } while (0)
struct XcdBarrier { unsigned* bar; unsigned x; volatile LAS unsigned* st; };
__device__ __forceinline__ XcdBarrier xcd_barrier_post(unsigned* bar, volatile LAS unsigned* st) {
    XcdBarrier b; b.bar = bar; b.x = xb_xcc_id(); b.st = st;
    if (threadIdx.x == 0) (void)xb_add(&bar[XB_XCNT(b.x)], 1u);
    return b;
}
__device__ __forceinline__ void xcd_barrier_complete(unsigned* bar, unsigned x, unsigned& nloc, unsigned& nx) {
    const unsigned G = gridDim.x * gridDim.y * gridDim.z;
    unsigned sum, cnt, mine, sp = 0u;
    for (;;) {
        sum = 0u; cnt = 0u; mine = 0u;
#pragma unroll
        for (unsigned j = 0; j < 16; ++j) { const unsigned c = xb_ld(&bar[XB_XCNT(j)]); sum += c; cnt += (c > 0u) ? 1u : 0u; mine = (j == x) ? c : mine; }
        if (sum == G) break;
        __builtin_amdgcn_s_sleep(1);
        if ((++sp & 255u) == 0u) { if (xb_ld(&bar[XB_TMO])) break; if (sp > XB_SPIN_CAP) { atomicAdd(&bar[XB_TMO], 1u); break; } }
    }
    nloc = mine > 0u ? mine : 1u; nx = cnt > 0u ? cnt : 1u;
}
__device__ __forceinline__ void xcd_barrier(const XcdBarrier& b) {
    asm volatile("s_waitcnt vmcnt(0)" ::: "memory");
    __syncthreads();
    if (threadIdx.x == 0) {
        unsigned* bar = b.bar;
        __builtin_amdgcn_s_waitcnt(0);
        unsigned nloc = b.st[0], nx = b.st[1];
        if (nloc == 0u) { xcd_barrier_complete(bar, b.x, nloc, nx); b.st[0] = nloc; b.st[1] = nx; }
        const unsigned old = xb_add(&bar[XB_XSUB(b.x)], 1u);
        const unsigned gen = old / nloc;
        if (old + 1u == (gen + 1u) * nloc) {
            __builtin_amdgcn_fence(__ATOMIC_RELEASE, "agent");
            asm volatile("s_waitcnt vmcnt(0)" ::: "memory");
            const unsigned og = xb_add(&bar[XB_TOP], 1u);
            const unsigned tg = og / nx;
            if (og + 1u == (tg + 1u) * nx) xb_add(&bar[XB_TOPGEN], 1u);
            else XB_SPIN(xb_ld(&bar[XB_TOPGEN]) == tg, bar);
            __builtin_amdgcn_fence(__ATOMIC_ACQUIRE, "agent");
            xb_add(&bar[XB_XGEN(b.x)], 1u);
            asm volatile("s_waitcnt vmcnt(0)" ::: "memory");
        } else {
            XB_SPIN(xb_ld(&bar[XB_XGEN(b.x)]) == gen, bar);
            __builtin_amdgcn_fence(__ATOMIC_ACQUIRE, "agent");
            asm volatile("s_waitcnt vmcnt(0)" ::: "memory");
        }
    }
    __syncthreads();
}

struct Args {
    const float* x; const float* w_in; const float* conv_w; const float* gate_bias; const float* ml_norm_g; const float* attn_sink; const float* w_out;
    const float* g_pre_mix; const float* g_post_mix; const float* g_pre_mlp; const float* g_post_mlp; const float* w_up; const float* w_down;
    float* out; unsigned char* ws; int ph_lo, ph_hi;
};

__global__ void __launch_bounds__(512, 2) mega(Args a) {
    extern __shared__ __attribute__((aligned(16))) unsigned char lds_raw[];
    LAS unsigned char* lds = (LAS unsigned char*)lds_raw;
    cg::grid_group grid = cg::this_grid();
    unsigned char* ws = a.ws;
    bf16_t* proj = (bf16_t*)(ws + WS_PROJ); bf16_t* qc = (bf16_t*)(ws + WS_QC); bf16_t* kc = (bf16_t*)(ws + WS_KC); bf16_t* Cb = (bf16_t*)(ws + WS_CB);
    float* gates = (float*)(ws + WS_GATES); float* nb = (float*)(ws + WS_NB); float* mloc = (float*)(ws + WS_ML); float* gch = (float*)(ws + WS_GC); float* mprev = (float*)(ws + WS_MP);
    bf16_t* ubuf = (bf16_t*)(ws + WS_U); bf16_t* mixA = (bf16_t*)(ws + WS_MIXO); bf16_t* mixB = (bf16_t*)(ws + WS_HB);
    bf16_t* hb = (bf16_t*)a.out;
    bf16_t* W0 = (bf16_t*)(ws + WS_W0); bf16_t* W1 = (bf16_t*)(ws + WS_W1); bf16_t* W2 = (bf16_t*)(ws + WS_W2);

    volatile LAS unsigned* xb_st = (volatile LAS unsigned*)(lds + LDS_BYTES - 16);
    if (threadIdx.x < 4) xb_st[threadIdx.x] = 0u;
    __syncthreads();
    XcdBarrier xbar = xcd_barrier_post((unsigned*)(ws + WS_BAR), xb_st);
    for (int ph = a.ph_lo; ph < a.ph_hi; ++ph) {
        int tid = threadIdx.x; asm volatile("" : "+v"(tid));
        const int lane = tid & 63, wave = __builtin_amdgcn_readfirstlane(tid >> 6);
        const int gw = blockIdx.x * 8 + wave, NGW = gridDim.x * 8;
        LAS float* scr = (LAS float*)(lds + wave * 16640);
        const int l = (ph == 0) ? 0 : (ph - 1) / 10, pt = (ph == 0) ? -1 : (ph - 1) % 10;
        if (ph == 0 && (PHMASK & 1)) {
            convert_win(a.w_in, W0, scr, lane, gw, NGW);
            convert_plain(a.w_out, DM, DM, W2, scr, lane, gw, NGW);
            row_phase(a.x, nullptr, nullptr, nullptr, nullptr, nullptr, a.g_pre_mix, hb, lane, gw, NGW);
        } else if ((PHMASK & 2) && (pt == 0 || pt == 5 || pt == 7 || pt == 8)) {
            pg8::Gemm g; pg8::Epi E; E.gates = gates; E.gate_pn = -1; E.act = 0;
            if (pt == 0)      { g = pg8::Gemm{hb, W0, T, NIN, DM, DM};      E.O = proj; E.ldc = NPROJ; E.gate_pn = 18; }
            else if (pt == 5) { g = pg8::Gemm{proj, W2, T, DM, DM, NPROJ};  E.O = mixA; E.ldc = DM; }
            else if (pt == 7) { g = pg8::Gemm{hb, W0, T, FF, DM, DM};       E.O = ubuf; E.ldc = FF; E.act = 1; }
            else              { g = pg8::Gemm{ubuf, W1, T, DM, FF, FF};     E.O = mixB; E.ldc = DM; }
            pg8::StaticOrder S; S.init(g.M, g.N, (int)gridDim.x, (int)blockIdx.x);
            pg8::gemm_phase(lds, g, S, E, tid);
            if (pt == 0) {
                const int rem = (T / 256) * (NIN / 256) % (int)gridDim.x;
                if (rem != 0 && (int)blockIdx.x >= rem) { __syncthreads();
                    convert_plain(a.w_down + (size_t)l * FF * DM, FF, DM, W1, scr, lane, ((int)blockIdx.x - rem) * 8 + wave, ((int)gridDim.x - rem) * 8); }
            }
        } else if ((PHMASK & 4) && pt == 1) {
            prep_phase(proj, a.conv_w + (size_t)l * 3 * 1024, qc, kc, lane, gw, NGW);
        } else if ((PHMASK & 8) && pt == 2) {
            for (int it = blockIdx.x; it < 1536; it += gridDim.x) {
                if (it < 1024) { if (PHMASK & 64) attn_item(it, proj, a.attn_sink + l * 8, lds, tid); }
                else mlstm_local_item(it - 1024, proj, kc, gates, a.gate_bias + l * 16, Cb, nb, mloc, gch, lds, tid);
            }
        } else if ((PHMASK & 16) && pt == 3) {
            mlstm_scan(Cb, nb, mloc, gch, mprev, tid);
        } else if ((PHMASK & 32) && pt == 4) {
            for (int it = blockIdx.x; it < 512; it += gridDim.x)
                mlstm_out_item(it, proj, qc, kc, gates, a.gate_bias + l * 16, Cb, nb, mprev, a.ml_norm_g + l * 1024, lds, tid);
        } else if ((PHMASK & 128) && pt == 6) {
            __syncthreads();
            convert_plain(a.w_up + (size_t)l * DM * FF, DM, FF, W0, scr, lane, gw, NGW);
            if ((T / 256) * (NIN / 256) % (int)gridDim.x == 0) convert_plain(a.w_down + (size_t)l * FF * DM, FF, DM, W1, scr, lane, gw, NGW);
            if (l == 0) row_phase(a.x, nullptr, mixA, a.g_post_mix, mixA, nullptr, a.g_pre_mlp, hb, lane, gw, NGW);
            else row_phase_b<3>(mixB, mixA, a.g_post_mix + DM, mixA, nullptr, a.g_pre_mlp + DM, hb, lane, gw, NGW);
        } else if (PHMASK & 256) {
            __syncthreads();
            if (l == 0) {
                convert_win(a.w_in + (size_t)DM * INCOLS, W0, scr, lane, gw, NGW);
                convert_plain(a.w_out + (size_t)DM * DM, DM, DM, W2, scr, lane, gw, NGW);
            }
            row_phase_b<3>(mixA, mixB, a.g_post_mlp + l * DM, l == 0 ? mixB : nullptr, l == 0 ? nullptr : a.out, l == 0 ? a.g_pre_mix + DM : nullptr, hb, lane, gw, NGW);
        }
        if (ph + 1 < a.ph_hi) { if (a.ph_hi > 1000) grid.sync(); else xcd_barrier(xbar); }
    }
}


#ifndef DBG_NPH
#define DBG_NPH 0
#endif
#if DBG_NPH
__global__ void dbg_dump(const unsigned short* src, size_t n, float* out, int nout) {
    for (size_t i = (size_t)blockIdx.x * blockDim.x + threadIdx.x; i < (size_t)nout; i += (size_t)gridDim.x * blockDim.x) {
        float s = 0.f;
        for (int k = 0; k < 4; ++k) { const size_t j = 4 * i + k; if (j < n) { const unsigned short b = src[j]; if ((b & 0x7f80u) == 0x7f80u) { const int col = (int)(j % 4608); s = col < 1024 ? 1.0e6f : (col < 2048 ? 3.0e6f : 7.0e6f); } } }
        out[i] = s; }
}
#endif
extern "C" void kernel_launch(void* const* d_in, const int* in_sizes, int n_in, void* d_out, int out_size, void* d_ws, size_t ws_size, hipStream_t stream) {
    static int grid = 0;
    if (grid == 0) {
        int dev = 0, cus = 0, per_cu = 0;
        (void)hipGetDevice(&dev);
        (void)hipDeviceGetAttribute(&cus, hipDeviceAttributeMultiprocessorCount, dev);
        if (hipFuncSetAttribute((const void*)mega, hipFuncAttributeMaxDynamicSharedMemorySize, LDS_BYTES) != hipSuccess) fprintf(stderr, "kernel_launch: hipFuncSetAttribute failed\n");
        if (hipOccupancyMaxActiveBlocksPerMultiprocessor(&per_cu, (const void*)mega, 512, LDS_BYTES) != hipSuccess || per_cu < 1) { fprintf(stderr, "kernel_launch: occupancy query says %d\n", per_cu); per_cu = 1; }
        (void)hipGetLastError();
        if (cus <= 0) cus = 256;
        grid = cus;
        if (ws_size < WS_END) fprintf(stderr, "kernel_launch: workspace too small: %zu < %zu\n", ws_size, (size_t)WS_END);
    }
    Args a{};
    a.x = (const float*)d_in[0]; a.w_in = (const float*)d_in[1]; a.conv_w = (const float*)d_in[2]; a.gate_bias = (const float*)d_in[3]; a.ml_norm_g = (const float*)d_in[4];
    a.attn_sink = (const float*)d_in[5]; a.w_out = (const float*)d_in[6]; a.g_pre_mix = (const float*)d_in[7]; a.g_post_mix = (const float*)d_in[8]; a.g_pre_mlp = (const float*)d_in[9];
    a.g_post_mlp = (const float*)d_in[10]; a.w_up = (const float*)d_in[11]; a.w_down = (const float*)d_in[12];
    a.out = (float*)d_out; a.ws = (unsigned char*)d_ws;
#if ONE_LAUNCH
    (void)hipMemsetAsync((unsigned char*)d_ws + WS_BAR, 0, 16384, stream);
    a.ph_lo = 0; a.ph_hi = NPH;
    void* args[] = {&a};
    hipError_t e = hipLaunchCooperativeKernel((const void*)mega, dim3(grid), dim3(512), args, LDS_BYTES, stream);
    if (e != hipSuccess) fprintf(stderr, "cooperative launch failed: %s (grid %d)\n", hipGetErrorString(e), grid);
#else
#if DBG_NPH
    for (int p = 0; p < DBG_NPH; ++p) { a.ph_lo = p; a.ph_hi = p + 1; hipLaunchKernelGGL(mega, dim3(grid), dim3(512), LDS_BYTES, stream, a); }
    hipLaunchKernelGGL(dbg_dump, dim3(2048), dim3(256), 0, stream, (const unsigned short*)((const unsigned char*)d_ws + DBG_OFF), (size_t)DBG_N, (float*)d_out, out_size);
#else
    for (int p = 0; p < NPH; ++p) { a.ph_lo = p; a.ph_hi = p + 1; hipLaunchKernelGGL(mega, dim3(grid), dim3(512), LDS_BYTES, stream, a); }
#endif
#endif
}
```

```cpp
#include <hip/hip_runtime.h>
#include <hip/hip_cooperative_groups.h>
#include <cstdio>
#include <cstdint>
namespace cg = cooperative_groups;

#ifndef PHMASK
#define PHMASK 0xFFFF
#endif
#ifndef ONE_LAUNCH
#define ONE_LAUNCH 1
#endif

#define LAS __attribute__((address_space(3)))
typedef unsigned short bf16_t;
typedef short bf16x8 __attribute__((ext_vector_type(8)));
typedef short bf16x4 __attribute__((ext_vector_type(4)));
typedef float f32x4 __attribute__((ext_vector_type(4)));
typedef unsigned u32x4 __attribute__((ext_vector_type(4)));
typedef unsigned u32x2 __attribute__((ext_vector_type(2)));

constexpr int T = 16384, SEQ = 8192, DM = 2048, FF = 8192;
constexpr int INCOLS = 4624;
constexpr int NPROJ = 4608;
constexpr int NIN = 4864;
constexpr int PC_AQ = 0, PC_MO = 1024, PC_AK = 2048, PC_AV = 2304, PC_MQ = 2560, PC_MK = 3072, PC_MV = 3584;
constexpr float NORM_EPS = 1e-6f;
constexpr int NPH = 21;
constexpr int LDS_BYTES = 163840;

constexpr size_t WS_U = 0;
constexpr size_t WS_PROJ = 0;
constexpr size_t WS_QC = 150994944;
constexpr size_t WS_KC = WS_QC + 16777216;
constexpr size_t WS_CB = WS_KC + 16777216;
constexpr size_t WS_GATES = WS_CB + 67108864;
constexpr size_t WS_NB = WS_GATES + 1048576;
constexpr size_t WS_ML = WS_NB + 524288;
constexpr size_t WS_GC = WS_ML + 4096;
constexpr size_t WS_MP = WS_GC + 4096;
constexpr int LDU = 8320;
constexpr size_t WS_MIXO = (size_t)16384 * 8320 * 2;
constexpr size_t WS_HB = WS_MIXO + 67108864;
constexpr size_t WS_W0 = WS_HB + 67108864;
constexpr size_t WS_W1 = WS_W0 + 33554432;
constexpr size_t WS_W2 = WS_W1 + 33554432;
constexpr size_t WS_BAR = WS_W2 + 8388608;
constexpr size_t WS_END = WS_BAR + 16384;
static_assert(WS_MP + 4096 <= WS_MIXO, "overlay");

typedef __bf16 bf16v2_t __attribute__((ext_vector_type(2)));
typedef float f32x2_t __attribute__((ext_vector_type(2)));
__device__ __forceinline__ unsigned cvt_pk_bf16(float lo, float hi) { const f32x2_t v = {lo, hi}; const bf16v2_t b = __builtin_convertvector(v, bf16v2_t); return __builtin_bit_cast(unsigned, b); }
__device__ __forceinline__ bf16_t f2bf(float x) { return (bf16_t)(cvt_pk_bf16(x, 0.f) & 0xffffu); }
__device__ __forceinline__ float bf2f(bf16_t b) { return __uint_as_float(((unsigned)b) << 16); }
__device__ __forceinline__ float bflo(unsigned w) { return __uint_as_float(w << 16); }
__device__ __forceinline__ float bfhi(unsigned w) { return __uint_as_float(w & 0xffff0000u); }
__device__ __forceinline__ float wave_sum(float v) {
#pragma unroll
    for (int o = 1; o < 64; o <<= 1) v += __shfl_xor(v, o);
    return v;
}
__device__ __forceinline__ float sigmoidf_(float y) { return 1.0f / (1.0f + __expf(-y)); }
__device__ __forceinline__ float logsigmoid_(float x) { return x < 0.f ? x - log1pf(expf(x)) : -log1pf(expf(-x)); }
#define MFMA16(a, b, c) __builtin_amdgcn_mfma_f32_16x16x32_bf16((a), (b), (c), 0, 0, 0)
#define LGKM0() asm volatile("s_waitcnt lgkmcnt(0)" ::: "memory")

namespace pg8 {
constexpr int BM = 256, BK = 64, HALF = 128, HTB = HALF * BK * 2, STAGE_BYTES = 8 * HTB, NXCD = 8, WGM = 8;
__host__ __device__ __forceinline__ int lds_byte(int r, int c) { const int st = (r >> 4) * 2 + (c >> 5), rr = r & 15, cc = c & 31, ob = rr * 64 + cc * 2; return st * 1024 + (ob ^ (((ob >> 9) & 1) << 5)); }
__host__ __device__ __forceinline__ void stage_rc(int b, int& R, int& C) { const int st = b / 1024, sb = b % 1024, swz = sb ^ (((sb >> 9) & 1) << 5); R = (st >> 1) * 16 + swz / 64; C = (st & 1) * 32 + (swz % 64) / 2; }
__host__ __device__ __forceinline__ int perm32(int rho) { const int n = rho >> 4, i = rho & 15; return 8 * (i >> 2) + 4 * n + (i & 3); }

struct Unit { int pm, pn; };
struct Gemm { const bf16_t* A; const bf16_t* Bt; int M, N, K, lda; };

struct StaticOrder {
    int nM, nN, nwg, G, c;
    __device__ void init(int M, int N, int G_, int c_) { nM = M / BM; nN = N / BM; nwg = nM * nN; G = G_; c = c_; }
    __device__ bool next(int i, Unit& u) const {
        const long L = (long)i * G + c; if (L >= nwg) return false;
        int wgid = (int)L; { const int q = nwg / NXCD, r = nwg % NXCD, xcd = wgid % NXCD, off = wgid / NXCD; wgid = (xcd < r ? xcd * (q + 1) : r * (q + 1) + (xcd - r) * q) + off; }
        const int nig = WGM * nN, gid = wgid / nig, fm = gid * WGM, gsz = (nM - fm) < WGM ? (nM - fm) : WGM;
        u.pm = fm + ((wgid % nig) % gsz); u.pn = (wgid % nig) / gsz; return true;
    }
};

struct Epi {
    bf16_t* O; int ldc; int act; float* gates; int gate_pn;
    __device__ __forceinline__ void operator()(const f32x4 (&acc)[2][2][4][2], const Unit& u, int wr, int wc, int fr, int fq) const {
        const int row0 = u.pm * BM + wr * 64 + fr;
        if (u.pn == gate_pn) {
            if (wc == 0 && fq < 2) {
#pragma unroll
                for (int ai = 0; ai < 2; ++ai)
#pragma unroll
                    for (int m = 0; m < 4; ++m) { float* gp = gates + (size_t)(row0 + ai * HALF + m * 16) * 16 + 8 * fq;
#pragma unroll
                        for (int n = 0; n < 2; ++n) *(f32x4*)(gp + 4 * n) = acc[ai][0][m][n]; }
            }
            return;
        }
        const int col0 = u.pn * BM + wc * 32 + 8 * fq;
#pragma unroll
        for (int ai = 0; ai < 2; ++ai)
#pragma unroll
            for (int m = 0; m < 4; ++m) { bf16_t* rowp = O + (size_t)(row0 + ai * HALF + m * 16) * ldc + col0;
#pragma unroll
                for (int bj = 0; bj < 2; ++bj) { f32x4 v0 = acc[ai][bj][m][0], v1 = acc[ai][bj][m][1];
                    if (act) {
#pragma unroll
                        for (int j = 0; j < 4; ++j) { const float a = fmaxf(v0[j], 0.f), b = fmaxf(v1[j], 0.f); v0[j] = a * a; v1[j] = b * b; } }
                    u32x4 w; w.x = cvt_pk_bf16(v0[0], v0[1]); w.y = cvt_pk_bf16(v0[2], v0[3]); w.z = cvt_pk_bf16(v1[0], v1[1]); w.w = cvt_pk_bf16(v1[2], v1[3]);
                    if (act) __builtin_nontemporal_store(w, (u32x4*)(rowp + bj * HALF)); else *(u32x4*)(rowp + bj * HALF) = w; } }
    }
};

__device__ __forceinline__ void gemm_phase(LAS unsigned char* lds, const Gemm g, const StaticOrder& S, const Epi& E, const int tid) {
    const int wid = __builtin_amdgcn_readfirstlane(tid >> 6), lane = tid & 63, wr = wid >> 2, wc = wid & 3, fr = lane & 15, fq = lane >> 4;
    const int K = g.K, nt = K / BK, lda = g.lda;
    unsigned voffA[2], voffB[2];
#pragma unroll
    for (int i = 0; i < 2; ++i) { int R, C; stage_rc(tid * 16 + i * 8192, R, C); const int Rb = (R & ~31) + perm32(R & 31);
        voffA[i] = (unsigned)(R * lda + C) * 2u; voffB[i] = (unsigned)(Rb * K + C) * 2u; }
    const size_t kstep = (size_t)(BK * 2);
    const size_t hstepA = (size_t)HALF * lda * 2, hstepB = (size_t)HALF * K * 2;
    const size_t tstepA = 2 * hstepA, tstepB = 2 * hstepB;
    const unsigned ldsw = (unsigned)wid * 1024u;
    const int aoff = lds_byte(wr * 64 + fr, fq * 8), boff = lds_byte(wc * 32 + fr, fq * 8);
#define PG8_SA(b, h) (((b) * 2 + (h)) * HTB)
#define PG8_SB(b, h) ((4 + (b) * 2 + (h)) * HTB)
#define PG8_STAGE(bufoff, gbase, voff) do { _Pragma("unroll") for (int _i = 0; _i < 2; ++_i) \
        __builtin_amdgcn_global_load_lds((const unsigned*)((const char*)(gbase) + (voff)[_i]), (LAS unsigned*)(lds + (bufoff) + ldsw + _i * 8192), 16, 0, 0); } while (0)
#define PG8_LDA(dst, b, h) do { _Pragma("unroll") for (int m = 0; m < 4; ++m) _Pragma("unroll") for (int k = 0; k < 2; ++k) dst[m][k] = *(const LAS bf16x8*)(lds + PG8_SA(b, h) + aoff + m * 2048 + k * 1024); } while (0)
#define PG8_LDB(dst, b, h) do { _Pragma("unroll") for (int n = 0; n < 2; ++n) _Pragma("unroll") for (int k = 0; k < 2; ++k) dst[n][k] = *(const LAS bf16x8*)(lds + PG8_SB(b, h) + boff + n * 2048 + k * 1024); } while (0)
#define PG8_MMA(ai, bj, At, Bt) do { __builtin_amdgcn_s_setprio(1); _Pragma("unroll") for (int m = 0; m < 4; ++m) _Pragma("unroll") for (int n = 0; n < 2; ++n) _Pragma("unroll") for (int k = 0; k < 2; ++k) \
        acc[ai][bj][m][n] = __builtin_amdgcn_mfma_f32_16x16x32_bf16(Bt[n][k], At[m][k], acc[ai][bj][m][n], 0, 0, 0); __builtin_amdgcn_s_setprio(0); } while (0)
#define PG8_WAIT_V(n) asm volatile("s_waitcnt vmcnt(" #n ")" ::: "memory")
#define PG8_WAIT_L(n) asm volatile("s_waitcnt lgkmcnt(" #n ")" ::: "memory")
#define PG8_BAR __builtin_amdgcn_s_barrier()
#define PG8_SCHED __builtin_amdgcn_sched_barrier(0)
    Unit cur, nxt; int ui = 0;
    if (!S.next(0, cur)) return;
    f32x4 acc[2][2][4][2];
#pragma unroll
    for (int a = 0; a < 2; ++a)
#pragma unroll
        for (int b = 0; b < 2; ++b)
#pragma unroll
            for (int m = 0; m < 4; ++m)
#pragma unroll
                for (int n = 0; n < 2; ++n) acc[a][b][m][n] = (f32x4){0.f, 0.f, 0.f, 0.f};
    bf16x8 At[4][2], B0[2][2], B1[2][2];
    const char* cA = (const char*)g.A + (size_t)cur.pm * tstepA; const char* cB = (const char*)g.Bt + (size_t)cur.pn * tstepB;
    PG8_STAGE(PG8_SB(0, 0), cB, voffB); PG8_STAGE(PG8_SB(0, 1), cB + hstepB, voffB); PG8_STAGE(PG8_SA(0, 0), cA, voffA); PG8_STAGE(PG8_SA(0, 1), cA + hstepA, voffA);
    if (wr == 1) PG8_BAR;
    PG8_WAIT_V(2); PG8_BAR;
    PG8_STAGE(PG8_SB(1, 0), cB + kstep, voffB); PG8_STAGE(PG8_SA(1, 0), cA + kstep, voffA); PG8_STAGE(PG8_SB(1, 1), cB + hstepB + kstep, voffB);
    PG8_WAIT_V(6); PG8_BAR;
    for (;;) {
        const bool has_next = S.next(ui + 1, nxt);
        const char* nA = has_next ? (const char*)g.A + (size_t)nxt.pm * tstepA : cA; const char* nB = has_next ? (const char*)g.Bt + (size_t)nxt.pn * tstepB : cB;
        for (int t = 0; t < nt; t += 2) {
            const bool last = (t == nt - 2);
            const char* a1 = cA + (size_t)(t + 1) * kstep;
            const char* a2 = last ? nA : cA + (size_t)(t + 2) * kstep; const char* b2 = last ? nB : cB + (size_t)(t + 2) * kstep;
            const char* a3 = a2 + kstep; const char* b3 = b2 + kstep;
            PG8_LDB(B0, 0, 0); PG8_LDB(B1, 0, 1); PG8_SCHED; PG8_LDA(At, 0, 0); PG8_STAGE(PG8_SA(1, 1), a1 + hstepA, voffA);
            PG8_WAIT_V(8); PG8_WAIT_L(0); PG8_BAR; PG8_MMA(0, 0, At, B0); PG8_MMA(0, 1, At, B1); PG8_BAR; PG8_SCHED;
            PG8_LDA(At, 0, 1); PG8_STAGE(PG8_SB(0, 0), b2, voffB); PG8_STAGE(PG8_SB(0, 1), b2 + hstepB, voffB); PG8_STAGE(PG8_SA(0, 0), a2, voffA);
            PG8_WAIT_V(8); PG8_WAIT_L(0); PG8_BAR; PG8_MMA(1, 0, At, B0); PG8_MMA(1, 1, At, B1); PG8_BAR; PG8_SCHED;
            PG8_LDB(B0, 1, 0); PG8_LDB(B1, 1, 1); PG8_SCHED; PG8_LDA(At, 1, 0); PG8_STAGE(PG8_SA(0, 1), a2 + hstepA, voffA);
            PG8_WAIT_V(8); PG8_WAIT_L(0); PG8_BAR; PG8_MMA(0, 0, At, B0); PG8_MMA(0, 1, At, B1); PG8_BAR; PG8_SCHED;
            PG8_LDA(At, 1, 1); PG8_STAGE(PG8_SB(1, 0), b3, voffB); PG8_STAGE(PG8_SB(1, 1), b3 + hstepB, voffB); PG8_STAGE(PG8_SA(1, 0), a3, voffA);
            PG8_WAIT_V(8); PG8_WAIT_L(0); PG8_BAR; PG8_MMA(1, 0, At, B0); PG8_MMA(1, 1, At, B1); PG8_BAR; PG8_SCHED;
        }
        if (wr == 0) PG8_BAR;
        E(acc, cur, wr, wc, fr, fq);
        if (!has_next) break;
#pragma unroll
        for (int a = 0; a < 2; ++a)
#pragma unroll
            for (int b = 0; b < 2; ++b)
#pragma unroll
                for (int m = 0; m < 4; ++m)
#pragma unroll
                    for (int n = 0; n < 2; ++n) acc[a][b][m][n] = (f32x4){0.f, 0.f, 0.f, 0.f};
        cur = nxt; cA = nA; cB = nB; ++ui;
        if (wr == 1) PG8_BAR;
    }
    PG8_WAIT_V(0);
    PG8_BAR;
#undef PG8_SA
#undef PG8_SB
#undef PG8_STAGE
#undef PG8_LDA
#undef PG8_LDB
#undef PG8_MMA
#undef PG8_WAIT_V
#undef PG8_WAIT_L
#undef PG8_BAR
#undef PG8_SCHED
}
}

__device__ __forceinline__ void t_load(const float* W, int ldw, int src_n0, int nvalid, int k0, int lane, f32x4 (&v)[16]) {
    const int n4 = lane & 15, kr = lane >> 4;
    const float* wp = W + (size_t)(k0 + kr) * ldw + src_n0 + 4 * n4;
    const bool ok = 4 * n4 < nvalid;
#pragma unroll
    for (int i = 0; i < 16; ++i) { v[i] = (f32x4){0.f, 0.f, 0.f, 0.f}; if (ok) v[i] = __builtin_nontemporal_load((const f32x4*)(wp + (size_t)(4 * i) * ldw)); }
}
__device__ __forceinline__ void t_store(const f32x4 (&v)[16], bf16_t* WT, int K, int dst_n0, int k0, LAS float* scr, int lane) {
    const int n4 = lane & 15, kr = lane >> 4;
#pragma unroll
    for (int i = 0; i < 16; ++i) { LAS float* d = scr + (4 * i + kr) * 65 + 4 * n4; d[0] = v[i][0]; d[1] = v[i][1]; d[2] = v[i][2]; d[3] = v[i][3]; }
    LGKM0();
    const int c8 = lane & 7;
#pragma unroll
    for (int j = 0; j < 8; ++j) { const int n = (lane >> 3) + 8 * j; const LAS float* sp = scr + (8 * c8) * 65 + n;
        u32x4 o; o.x = cvt_pk_bf16(sp[0 * 65], sp[1 * 65]); o.y = cvt_pk_bf16(sp[2 * 65], sp[3 * 65]); o.z = cvt_pk_bf16(sp[4 * 65], sp[5 * 65]); o.w = cvt_pk_bf16(sp[6 * 65], sp[7 * 65]);
        *(u32x4*)(WT + (size_t)(dst_n0 + n) * K + k0 + 8 * c8) = o; }
    LGKM0();
}
__device__ __forceinline__ int in_src_col(int n) {
    if (n < 1024) return n;
    if (n < 2048) return 3584 + (n - 1024);
    if (n < 2304) return 1024 + (n - 2048);
    if (n < 2560) return 1280 + (n - 2304);
    if (n < 3072) return 1536 + (n - 2560);
    if (n < 3584) return 2048 + (n - 3072);
    if (n < 4608) return 2560 + (n - 3584);
    return n;
}
template <bool WIN>
__device__ __forceinline__ void convert_w(const float* W, int K, int N, bf16_t* WT, LAS float* scr, int lane, int gw, int NGW) {
    const int nblk = N / 64, items = (K / 64) * nblk, ldw = WIN ? INCOLS : N;
    int it = gw; if (it >= items) return;
    int k0 = 64 * (it / nblk), n0 = 64 * (it % nblk), src = n0, nvalid = 64;
    if (WIN) { src = in_src_col(n0); nvalid = INCOLS - src; nvalid = nvalid < 0 ? 0 : (nvalid > 64 ? 64 : nvalid); if (n0 < 4608) nvalid = 64; if (nvalid == 0) src = 0; }
    f32x4 v[16];
    t_load(W, ldw, src, nvalid, k0, lane, v);
    for (;;) {
        const int itn = it + NGW; const bool hn = itn < items;
        int k0n = 0, n0n = 0; f32x4 vn[16];
        if (hn) { k0n = 64 * (itn / nblk); n0n = 64 * (itn % nblk); int srcn = n0n, nvn = 64;
            if (WIN) { srcn = in_src_col(n0n); nvn = INCOLS - srcn; nvn = nvn < 0 ? 0 : (nvn > 64 ? 64 : nvn); if (n0n < 4608) nvn = 64; if (nvn == 0) srcn = 0; }
            t_load(W, ldw, srcn, nvn, k0n, lane, vn); }
        t_store(v, WT, K, n0, k0, scr, lane);
        if (!hn) break;
#pragma unroll
        for (int i = 0; i < 16; ++i) v[i] = vn[i];
        it = itn; k0 = k0n; n0 = n0n;
    }
}
__device__ __forceinline__ void convert_plain(const float* W, int K, int N, bf16_t* WT, LAS float* scr, int lane, int gw, int NGW) { convert_w<false>(W, K, N, WT, scr, lane, gw, NGW); }
__device__ __forceinline__ void convert_win(const float* W, bf16_t* WT, LAS float* scr, int lane, int gw, int NGW) { convert_w<true>(W, DM, NIN, WT, scr, lane, gw, NGW); }

__device__ __forceinline__ void row_phase(const float* xf, const bf16_t* xb, const bf16_t* y, const float* gpost, bf16_t* xob, float* xof, const float* gnext, bf16_t* hout, int lane, int gw, int NGW) {
    int m = gw; if (m >= T) return;
    f32x4 v[8]; u32x2 xw[8], yw[8];
    { if (xf) { const f32x4* xr = (const f32x4*)(xf + (size_t)m * DM) + lane;
#pragma unroll
          for (int j = 0; j < 8; ++j) v[j] = __builtin_nontemporal_load(xr + 64 * j); }
      else { const u32x2* xr = (const u32x2*)(xb + (size_t)m * DM) + lane;
#pragma unroll
          for (int j = 0; j < 8; ++j) xw[j] = __builtin_nontemporal_load(xr + 64 * j); }
      if (y) { const u32x2* yr = (const u32x2*)(y + (size_t)m * DM) + lane;
#pragma unroll
          for (int j = 0; j < 8; ++j) yw[j] = __builtin_nontemporal_load(yr + 64 * j); } }
    for (;;) {
        const int mn = m + NGW; const bool hn = mn < T;
        f32x4 vn[8]; u32x2 xwn[8], ywn[8];
        if (hn) {
            if (xf) { const f32x4* xr = (const f32x4*)(xf + (size_t)mn * DM) + lane;
#pragma unroll
                for (int j = 0; j < 8; ++j) vn[j] = __builtin_nontemporal_load(xr + 64 * j); }
            else { const u32x2* xr = (const u32x2*)(xb + (size_t)mn * DM) + lane;
#pragma unroll
                for (int j = 0; j < 8; ++j) xwn[j] = __builtin_nontemporal_load(xr + 64 * j); }
            if (y) { const u32x2* yr = (const u32x2*)(y + (size_t)mn * DM) + lane;
#pragma unroll
                for (int j = 0; j < 8; ++j) ywn[j] = __builtin_nontemporal_load(yr + 64 * j); } }
        if (!xf) {
#pragma unroll
            for (int j = 0; j < 8; ++j) v[j] = (f32x4){bflo(xw[j].x), bfhi(xw[j].x), bflo(xw[j].y), bfhi(xw[j].y)}; }
        if (y) {
            f32x4 yv[8]; float s = 0.f;
#pragma unroll
            for (int j = 0; j < 8; ++j) { const u32x2 w = yw[j]; yv[j] = (f32x4){bflo(w.x), bfhi(w.x), bflo(w.y), bfhi(w.y)};
                s += (yv[j][0] * yv[j][0] + yv[j][1] * yv[j][1]) + (yv[j][2] * yv[j][2] + yv[j][3] * yv[j][3]); }
            s = wave_sum(s);
            const float rstd = 1.0f / sqrtf(s * (1.0f / DM) + NORM_EPS);
#pragma unroll
            for (int j = 0; j < 8; ++j) { const f32x4 gg = ((const f32x4*)gpost)[lane + 64 * j]; v[j] = v[j] + yv[j] * rstd * gg; }
            if (xof) { f32x4* xo = (f32x4*)(xof + (size_t)m * DM) + lane;
#pragma unroll
                for (int j = 0; j < 8; ++j) __builtin_nontemporal_store(v[j], xo + 64 * j); }
            else { u32x2* xo = (u32x2*)(xob + (size_t)m * DM) + lane;
#pragma unroll
                for (int j = 0; j < 8; ++j) { u32x2 w; w.x = cvt_pk_bf16(v[j][0], v[j][1]); w.y = cvt_pk_bf16(v[j][2], v[j][3]); __builtin_nontemporal_store(w, xo + 64 * j); } }
        }
        if (gnext) {
            float s = 0.f;
#pragma unroll
            for (int j = 0; j < 8; ++j) s += (v[j][0] * v[j][0] + v[j][1] * v[j][1]) + (v[j][2] * v[j][2] + v[j][3] * v[j][3]);
            s = wave_sum(s);
            const float rstd = 1.0f / sqrtf(s * (1.0f / DM) + NORM_EPS);
            u32x2* ho = (u32x2*)(hout + (size_t)m * DM) + lane;
#pragma unroll
            for (int j = 0; j < 8; ++j) { const f32x4 gg = ((const f32x4*)gnext)[lane + 64 * j]; const f32x4 o = v[j] * rstd * gg;
                u32x2 w; w.x = cvt_pk_bf16(o[0], o[1]); w.y = cvt_pk_bf16(o[2], o[3]); ho[64 * j] = w; }
        }
        if (!hn) break;
#pragma unroll
        for (int j = 0; j < 8; ++j) { v[j] = vn[j]; xw[j] = xwn[j]; yw[j] = ywn[j]; }
        m = mn;
    }
}

template <int R>
__device__ __forceinline__ void row_phase_b(const bf16_t* xb, const bf16_t* y, const float* gpost, bf16_t* xob, float* xof, const float* gnext, bf16_t* hout, int lane, int gw, int NGW) {
    if (gw >= T) return;
    const int nrows = (T - gw + NGW - 1) / NGW;
    u32x2 xw[R][8], yw[R][8];
#pragma unroll
    for (int i = 0; i < R; ++i) if (i < nrows) { const size_t m = (size_t)gw + (size_t)i * NGW;
        const u32x2* xr = (const u32x2*)(xb + m * DM) + lane; const u32x2* yr = (const u32x2*)(y + m * DM) + lane;
#pragma unroll
        for (int j = 0; j < 8; ++j) { xw[i][j] = __builtin_nontemporal_load(xr + 64 * j); yw[i][j] = __builtin_nontemporal_load(yr + 64 * j); } }
    for (int k0 = 0; k0 < nrows; k0 += R) {
#pragma unroll
        for (int i = 0; i < R; ++i) { const int k = k0 + i;
            if (k < nrows) {
                const size_t m = (size_t)gw + (size_t)k * NGW;
                f32x4 v[8], yv[8]; float s = 0.f;
#pragma unroll
                for (int j = 0; j < 8; ++j) { const u32x2 a = xw[i][j], w = yw[i][j];
                    v[j] = (f32x4){bflo(a.x), bfhi(a.x), bflo(a.y), bfhi(a.y)}; yv[j] = (f32x4){bflo(w.x), bfhi(w.x), bflo(w.y), bfhi(w.y)};
                    s += (yv[j][0] * yv[j][0] + yv[j][1] * yv[j][1]) + (yv[j][2] * yv[j][2] + yv[j][3] * yv[j][3]); }
                if (k + R < nrows) { const size_t mn = (size_t)gw + (size_t)(k + R) * NGW;
                    const u32x2* xr = (const u32x2*)(xb + mn * DM) + lane; const u32x2* yr = (const u32x2*)(y + mn * DM) + lane;
#pragma unroll
                    for (int j = 0; j < 8; ++j) { xw[i][j] = __builtin_nontemporal_load(xr + 64 * j); yw[i][j] = __builtin_nontemporal_load(yr + 64 * j); } }
                s = wave_sum(s);
                const float rstd = 1.0f / sqrtf(s * (1.0f / DM) + NORM_EPS);
#pragma unroll
                for (int j = 0; j < 8; ++j) { const f32x4 gg = ((const f32x4*)gpost)[lane + 64 * j]; v[j] = v[j] + yv[j] * rstd * gg; }
                if (xof) { f32x4* xo = (f32x4*)(xof + m * DM) + lane;
#pragma unroll
                    for (int j = 0; j < 8; ++j) __builtin_nontemporal_store(v[j], xo + 64 * j); }
                else { u32x2* xo = (u32x2*)(xob + m * DM) + lane;
#pragma unroll
                    for (int j = 0; j < 8; ++j) { u32x2 w; w.x = cvt_pk_bf16(v[j][0], v[j][1]); w.y = cvt_pk_bf16(v[j][2], v[j][3]); __builtin_nontemporal_store(w, xo + 64 * j); } }
                if (gnext) {
                    float s2 = 0.f;
#pragma unroll
                    for (int j = 0; j < 8; ++j) s2 += (v[j][0] * v[j][0] + v[j][1] * v[j][1]) + (v[j][2] * v[j][2] + v[j][3] * v[j][3]);
                    s2 = wave_sum(s2);
                    const float rstd2 = 1.0f / sqrtf(s2 * (1.0f / DM) + NORM_EPS);
                    u32x2* ho = (u32x2*)(hout + m * DM) + lane;
#pragma unroll
                    for (int j = 0; j < 8; ++j) { const f32x4 gg = ((const f32x4*)gnext)[lane + 64 * j]; const f32x4 o = v[j] * rstd2 * gg;
                        u32x2 w; w.x = cvt_pk_bf16(o[0], o[1]); w.y = cvt_pk_bf16(o[2], o[3]); ho[64 * j] = w; }
                }
            }
        }
    }
}

__device__ __forceinline__ void prep_phase(bf16_t* proj, const float* convw, bf16_t* qc, bf16_t* kc, int lane, int gw, int NGW) {
    if (gw >= T) return;
    constexpr int R = 4;
    const int nrows = (T - gw + NGW - 1) / NGW;
    const float invf = exp2f(-(float)lane * (13.287712379549449f / 64.0f));
    float cw[2][3][8];
#pragma unroll
    for (int jj = 0; jj < 2; ++jj)
#pragma unroll
        for (int tp = 0; tp < 3; ++tp) { const f32x4 w0 = *(const f32x4*)(convw + tp * 1024 + lane * 8 + 512 * jj), w1 = *(const f32x4*)(convw + tp * 1024 + lane * 8 + 512 * jj + 4);
            cw[jj][tp][0] = w0[0]; cw[jj][tp][1] = w0[1]; cw[jj][tp][2] = w0[2]; cw[jj][tp][3] = w0[3]; cw[jj][tp][4] = w1[0]; cw[jj][tp][5] = w1[1]; cw[jj][tp][6] = w1[2]; cw[jj][tp][7] = w1[3]; }
    u32x4 cur[R][2], prv[R][2], nxt[R][2]; bf16_t kx[R][4];
#define PREP_LOAD(slot, mrow) do { const size_t _m = (mrow); const int _pos = (int)(_m & (SEQ - 1)); const bf16_t* _pr = proj + _m * NPROJ; \
        _Pragma("unroll") for (int jj = 0; jj < 2; ++jj) { const int _ch = lane * 8 + 512 * jj; cur[slot][jj] = *(const u32x4*)(_pr + PC_MQ + _ch); \
            prv[slot][jj] = (u32x4){0u, 0u, 0u, 0u}; nxt[slot][jj] = (u32x4){0u, 0u, 0u, 0u}; \
            if (_pos > 0) prv[slot][jj] = *(const u32x4*)(_pr - NPROJ + PC_MQ + _ch); \
            if (_pos < SEQ - 1) nxt[slot][jj] = *(const u32x4*)(_pr + NPROJ + PC_MQ + _ch); } \
        kx[slot][0] = _pr[PC_AK + lane]; kx[slot][1] = _pr[PC_AK + 64 + lane]; kx[slot][2] = _pr[PC_AK + 128 + lane]; kx[slot][3] = _pr[PC_AK + 192 + lane]; } while (0)
#pragma unroll
    for (int i = 0; i < R; ++i) if (i < nrows) PREP_LOAD(i, (size_t)gw + (size_t)i * NGW);
    for (int k0 = 0; k0 < nrows; k0 += R) {
#pragma unroll
        for (int i = 0; i < R; ++i) { const int k = k0 + i;
            if (k < nrows) {
                const size_t m = (size_t)gw + (size_t)k * NGW;
                u32x4 c2[2], p2[2], n2[2]; bf16_t k4[4];
#pragma unroll
                for (int jj = 0; jj < 2; ++jj) { c2[jj] = cur[i][jj]; p2[jj] = prv[i][jj]; n2[jj] = nxt[i][jj]; }
#pragma unroll
                for (int q = 0; q < 4; ++q) k4[q] = kx[i][q];
                if (k + R < nrows) PREP_LOAD(i, (size_t)gw + (size_t)(k + R) * NGW);
                const int pos = (int)(m & (SEQ - 1));
                const float ang = (float)pos * invf;
                const double rev = (double)ang * 0.15915494309189535; const float f = (float)(rev - rint(rev));
                const float sn = __builtin_amdgcn_sinf(f), cs = __builtin_amdgcn_cosf(f);
                bf16_t* pr = proj + m * NPROJ;
#pragma unroll
                for (int hh = 0; hh < 2; ++hh) { const int base = PC_AK + hh * 128;
                    const float x1 = bf2f(k4[2 * hh]), x2 = bf2f(k4[2 * hh + 1]);
                    pr[base + lane] = f2bf(x1 * cs - x2 * sn); pr[base + 64 + lane] = f2bf(x2 * cs + x1 * sn); }
#pragma unroll
                for (int jj = 0; jj < 2; ++jj) { float yv[8];
#pragma unroll
                    for (int e = 0; e < 4; ++e) {
                        const float ya = cw[jj][0][2 * e] * bflo(p2[jj][e]) + cw[jj][1][2 * e] * bflo(c2[jj][e]) + cw[jj][2][2 * e] * bflo(n2[jj][e]);
                        const float yb = cw[jj][0][2 * e + 1] * bfhi(p2[jj][e]) + cw[jj][1][2 * e + 1] * bfhi(c2[jj][e]) + cw[jj][2][2 * e + 1] * bfhi(n2[jj][e]);
                        yv[2 * e] = ya * sigmoidf_(ya); yv[2 * e + 1] = yb * sigmoidf_(yb); }
                    if (jj == 0) {
#pragma unroll
                        for (int e = 0; e < 8; ++e) yv[e] *= 0.08838834764831845f; }
                    u32x4 o; o.x = cvt_pk_bf16(yv[0], yv[1]); o.y = cvt_pk_bf16(yv[2], yv[3]); o.z = cvt_pk_bf16(yv[4], yv[5]); o.w = cvt_pk_bf16(yv[6], yv[7]);
                    *(u32x4*)((jj == 0 ? qc : kc) + m * 512 + lane * 8) = o; }
            }
        }
    }
#undef PREP_LOAD
}

__device__ __forceinline__ void stage_nat128(const bf16_t* src, long ld, int nrows, int lo, int hi, LAS bf16_t* dst, int tid) {
    for (int idx = tid; idx < nrows * 16; idx += 512) { const int row = idx >> 4, c8 = idx & 15; u32x4 v = (u32x4){0u, 0u, 0u, 0u};
        if (row >= lo && row < hi) v = *(const u32x4*)(src + (long)row * ld + c8 * 8);
        *(LAS u32x4*)(dst + row * 136 + c8 * 8) = v; }
}
__device__ __forceinline__ void stage_T(const bf16_t* src, long ld, int nrows, int ncols, int lo, int hi, LAS bf16_t* dst, int VS, const LAS float* rowscale, int tid) {
    const int nrb = nrows >> 5, total = nrows * (ncols >> 3);
    for (int idx = tid; idx < total; idx += 512) {
        const int rlo = idx & 31, cl = (idx >> 5) & 1, rest = idx >> 6, rowblk = rest % nrb, cp = rest / nrb;
        const int row = rowblk * 32 + rlo, chunk = 2 * cp + cl;
        u32x4 v = (u32x4){0u, 0u, 0u, 0u};
        if (row >= lo && row < hi) v = *(const u32x4*)(src + (long)row * ld + chunk * 8);
        LAS bf16_t* d = dst + (chunk * 8) * VS + row;
        if (rowscale) { const float sc = rowscale[row];
#pragma unroll
            for (int e = 0; e < 4; ++e) { const unsigned w = cvt_pk_bf16(bflo(v[e]) * sc, bfhi(v[e]) * sc); d[(2 * e) * VS] = (bf16_t)(w & 0xffffu); d[(2 * e + 1) * VS] = (bf16_t)(w >> 16); }
        } else {
#pragma unroll
            for (int e = 0; e < 4; ++e) { d[(2 * e) * VS] = (bf16_t)(v[e] & 0xffffu); d[(2 * e + 1) * VS] = (bf16_t)(v[e] >> 16); }
        }
    }
}
__device__ __forceinline__ bf16x8 ld_pair(const LAS bf16_t* p0, const LAS bf16_t* p1) {
    const bf16x4 lo = *(const LAS bf16x4*)p0, hi = *(const LAS bf16x4*)p1;
    return __builtin_shufflevector(lo, hi, 0, 1, 2, 3, 4, 5, 6, 7);
}
__device__ __forceinline__ bf16x8 pack8(const f32x4 a, const f32x4 b) {
    u32x4 w; w.x = cvt_pk_bf16(a[0], a[1]); w.y = cvt_pk_bf16(a[2], a[3]); w.z = cvt_pk_bf16(b[0], b[1]); w.w = cvt_pk_bf16(b[2], b[3]);
    return (bf16x8)w;
}

template <int N> __device__ __forceinline__ void ld_nat(const bf16_t* src, long ld, int lo, int hi, int tid, u32x4 (&v)[N]) {
#pragma unroll
    for (int i = 0; i < N; ++i) { const int idx = tid + 512 * i, row = idx >> 4, c8 = idx & 15; v[i] = (u32x4){0u, 0u, 0u, 0u};
        if (row >= lo && row < hi) v[i] = *(const u32x4*)(src + (long)row * ld + c8 * 8); }
}
template <int N> __device__ __forceinline__ void st_nat(const u32x4 (&v)[N], LAS bf16_t* dst, int tid) {
    asm volatile("" : "+v"(tid));
#pragma unroll
    for (int i = 0; i < N; ++i) { const int idx = tid + 512 * i, row = idx >> 4, c8 = idx & 15; *(LAS u32x4*)(dst + row * 136 + c8 * 8) = v[i]; }
}
template <int N, int NROWS> __device__ __forceinline__ void ld_T(const bf16_t* src, long ld, int lo, int hi, int tid, u32x4 (&v)[N]) {
    constexpr int nrb = NROWS >> 5;
#pragma unroll
    for (int i = 0; i < N; ++i) { const int idx = tid + 512 * i, rlo = idx & 31, cl = (idx >> 5) & 1, rest = idx >> 6, rowblk = rest % nrb, cp = rest / nrb;
        const int row = rowblk * 32 + rlo, chunk = 2 * cp + cl; v[i] = (u32x4){0u, 0u, 0u, 0u};
        if (row >= lo && row < hi) v[i] = *(const u32x4*)(src + (long)row * ld + chunk * 8); }
}
template <int N, int NROWS> __device__ __forceinline__ void st_T(const u32x4 (&v)[N], LAS bf16_t* dst, int VS, const LAS float* rowscale, int tid) {
    constexpr int nrb = NROWS >> 5;
    asm volatile("" : "+v"(tid));
#pragma unroll
    for (int i = 0; i < N; ++i) { const int idx = tid + 512 * i, rlo = idx & 31, cl = (idx >> 5) & 1, rest = idx >> 6, rowblk = rest % nrb, cp = rest / nrb;
        const int row = rowblk * 32 + rlo, chunk = 2 * cp + cl;
        LAS bf16_t* d = dst + (chunk * 8) * VS + row;
        if (rowscale) { const float sc = rowscale[row];
#pragma unroll
            for (int e = 0; e < 4; ++e) { const unsigned w = cvt_pk_bf16(bflo(v[i][e]) * sc, bfhi(v[i][e]) * sc); d[(2 * e) * VS] = (bf16_t)(w & 0xffffu); d[(2 * e + 1) * VS] = (bf16_t)(w >> 16); }
        } else {
#pragma unroll
            for (int e = 0; e < 4; ++e) { d[(2 * e) * VS] = (bf16_t)(v[i][e] & 0xffffu); d[(2 * e + 1) * VS] = (bf16_t)(v[i][e] >> 16); }
        } }
}

__device__ __forceinline__ void attn_item(int item, bf16_t* proj, const float* sink, LAS unsigned char* lds, int tid) {
    const int j = item & 63, qh = (item >> 6) & 7, b = item >> 9, kvh = qh >> 2;
    const int wave = tid >> 6, lane = tid & 63, r = lane & 15, fq = lane >> 4;
    LAS bf16_t* Ks = (LAS bf16_t*)lds;
    LAS bf16_t* Vt = (LAS bf16_t*)lds;
    const int kpos0 = j * 128 - 128;
    const int lo = kpos0 < 0 ? -kpos0 : 0, hi = (kpos0 + 384 > SEQ) ? SEQ - kpos0 : 384;
    const bf16_t* kbase = proj + ((long)b * SEQ + kpos0) * NPROJ + PC_AK + kvh * 128;
    const bf16_t* vbase = proj + ((long)b * SEQ + kpos0) * NPROJ + PC_AV + kvh * 128;
    __syncthreads();
    stage_nat128(kbase, NPROJ, 384, lo, hi, Ks, tid);
    bf16_t* qrow = proj + ((size_t)b * SEQ + j * 128 + wave * 16 + r) * NPROJ + PC_AQ + qh * 128;
    bf16x8 qf[4];
#pragma unroll
    for (int ks = 0; ks < 4; ++ks) qf[ks] = *(const bf16x8*)(qrow + ks * 32 + fq * 8);
    {
        const float posf = (float)(j * 128 + wave * 16 + r);
#pragma unroll
        for (int k2 = 0; k2 < 2; ++k2) { const u32x4 xa = (u32x4)qf[k2], xb = (u32x4)qf[k2 + 2]; float y1[8], y2[8];
#pragma unroll
            for (int e = 0; e < 8; ++e) { const float invf = exp2f(-(float)(k2 * 32 + fq * 8 + e) * (13.287712379549449f / 64.0f));
                const float ang = posf * invf; const double rev = (double)ang * 0.15915494309189535; const float fr = (float)(rev - rint(rev));
                const float sn = __builtin_amdgcn_sinf(fr), cs = __builtin_amdgcn_cosf(fr);
                const float x1 = (e & 1) ? bfhi(xa[e >> 1]) : bflo(xa[e >> 1]), x2 = (e & 1) ? bfhi(xb[e >> 1]) : bflo(xb[e >> 1]);
                y1[e] = x1 * cs - x2 * sn; y2[e] = x2 * cs + x1 * sn; }
            u32x4 oa, ob;
#pragma unroll
            for (int e = 0; e < 4; ++e) { oa[e] = cvt_pk_bf16(y1[2 * e], y1[2 * e + 1]); ob[e] = cvt_pk_bf16(y2[2 * e], y2[2 * e + 1]); }
            qf[k2] = (bf16x8)oa; qf[k2 + 2] = (bf16x8)ob; } }
    __syncthreads();
    const int w = __builtin_amdgcn_readfirstlane(wave);
    const bool jf = (j != 0), jl = (j != 63);
#define ATT_TV(st) ((st) < 8 ? ((st) >= w && jf) : ((st) < 16 ? true : (((st) - 16) <= w && jl)))
    f32x4 sacc[24];
#pragma unroll
    for (int st = 0; st < 24; ++st) { f32x4 a4 = (f32x4){0.f, 0.f, 0.f, 0.f};
        if (ATT_TV(st)) {
#pragma unroll
            for (int ks = 0; ks < 4; ++ks) { const bf16x8 a = *(const LAS bf16x8*)(Ks + (16 * st + r) * 136 + ks * 32 + fq * 8); a4 = MFMA16(a, qf[ks], a4); } }
        sacc[st] = a4; }
    const float cs2 = 0.08838834764831845f * 1.4426950408889634f;
    const float snk2 = sink[qh] * 1.4426950408889634f;
    float mx = -3.0e38f;
#pragma unroll
    for (int st = 0; st < 24; ++st) {
        if (ATT_TV(st)) {
#pragma unroll
            for (int jj = 0; jj < 4; ++jj) { float sv = sacc[st][jj];
                if (st < 8) { if (st == w) sv = (4 * fq + jj >= r) ? sv : -3.0e38f; }
                else if (st >= 16) { if (st - 16 == w) sv = (4 * fq + jj <= r) ? sv : -3.0e38f; }
                sacc[st][jj] = sv; mx = fmaxf(mx, sv); } } }
    mx = fmaxf(mx, __shfl_xor(mx, 16)); mx = fmaxf(mx, __shfl_xor(mx, 32));
    const float m2 = fmaxf(mx * cs2, snk2);
    float sum = 0.f;
#pragma unroll
    for (int st = 0; st < 24; ++st) {
        if (ATT_TV(st)) {
#pragma unroll
            for (int jj = 0; jj < 4; ++jj) { const float p = __builtin_amdgcn_exp2f(fmaf(sacc[st][jj], cs2, -m2)); sacc[st][jj] = p; sum += p; } }
        else sacc[st] = (f32x4){0.f, 0.f, 0.f, 0.f}; }
    sum += __shfl_xor(sum, 16); sum += __shfl_xor(sum, 32);
    const float inv = 1.0f / (sum + __builtin_amdgcn_exp2f(snk2 - m2));
    bf16x8 pb[12];
#pragma unroll
    for (int kp = 0; kp < 12; ++kp) pb[kp] = pack8(sacc[2 * kp], sacc[2 * kp + 1]);
    __syncthreads();
    stage_T(vbase, NPROJ, 384, 128, lo, hi, Vt, 396, nullptr, tid);
    __syncthreads();
    f32x4 o[8];
#pragma unroll
    for (int dt = 0; dt < 8; ++dt) o[dt] = (f32x4){0.f, 0.f, 0.f, 0.f};
#pragma unroll
    for (int kp = 0; kp < 12; ++kp) {
        if (ATT_TV(2 * kp) || ATT_TV(2 * kp + 1)) {
            const LAS bf16_t* vr = Vt + r * 396 + 4 * fq + kp * 32;
#pragma unroll
            for (int dt = 0; dt < 8; ++dt) { const bf16x8 a = ld_pair(vr + dt * (16 * 396), vr + dt * (16 * 396) + 16); o[dt] = MFMA16(a, pb[kp], o[dt]); } } }
#pragma unroll
    for (int dt = 0; dt < 8; ++dt) { u32x2 wv; wv.x = cvt_pk_bf16(o[dt][0] * inv, o[dt][1] * inv); wv.y = cvt_pk_bf16(o[dt][2] * inv, o[dt][3] * inv);
        *(u32x2*)(qrow + 16 * dt + 4 * fq) = wv; }
#undef ATT_TV
}

__device__ __forceinline__ void mlstm_local_item(int item, const bf16_t* proj, const bf16_t* kc, const float* gates, const float* gbias, bf16_t* Cb, float* nb, float* mloc, float* gch,
                                                 LAS unsigned char* lds, int tid) {
    asm volatile("" : "+v"(tid));
    const int c = item & 63, h = (item >> 6) & 3, b = item >> 8;
    const int wave = tid >> 6, lane = tid & 63, r = lane & 15, fq = lane >> 4;
    const long row0 = (long)b * SEQ + c * 128;
    const int bh = b * 4 + h;
    LAS bf16_t* Kt = (LAS bf16_t*)lds;
    LAS bf16_t* Vt = (LAS bf16_t*)(lds + 33792);
    LAS float* lf = (LAS float*)(lds + 101376);
    LAS float* li = lf + 256; LAS float* aa = lf + 512; LAS float* we = lf + 768;
    u32x4 vreg[8], kreg[4]; float gi = 0.f, gf = 0.f;
    ld_T<8, 128>(proj + row0 * NPROJ + PC_MV + h * 256, NPROJ, 0, 128, tid, vreg);
    ld_T<4, 128>(kc + row0 * 512 + h * 128, 512, 0, 128, tid, kreg);
    if (tid < 256) { const int dir = tid >> 7, l = tid & 127;
        gi = gates[(row0 + l) * 16 + (2 * dir) * 4 + h] + gbias[(2 * dir) * 4 + h];
        gf = gates[(row0 + l) * 16 + (2 * dir + 1) * 4 + h] + gbias[(2 * dir + 1) * 4 + h]; }
    __syncthreads();
    if (tid < 256) { li[tid] = gi; lf[tid] = logsigmoid_(gf); }
    st_T<8, 128>(vreg, Vt, 132, nullptr, tid);
    __syncthreads();
    if (tid < 256) { const int dir = tid >> 7, l = tid & 127; float acc = 0.f, tot = 0.f;
        for (int q = 0; q < 128; ++q) { const float v = lf[dir * 128 + q]; tot += v; acc += (q <= l) ? v : 0.f; }
        if (dir) acc = tot - acc + lf[dir * 128 + l];
        aa[tid] = tot - acc + li[tid];
        if (l == 0) gch[(bh * 2 + dir) * 64 + c] = tot; }
    __syncthreads();
    if (tid < 256) { const int dir = tid >> 7, l = tid & 127; float mxx = -3.0e38f;
        for (int q = 0; q < 128; ++q) mxx = fmaxf(mxx, aa[dir * 128 + q]);
        we[tid] = expf(aa[tid] - mxx);
        if (l == 0) mloc[(bh * 2 + dir) * 64 + c] = mxx; }
    bf16x8 bfr[2][4];
#pragma unroll
    for (int dd = 0; dd < 2; ++dd)
#pragma unroll
        for (int ks = 0; ks < 4; ++ks) { const LAS bf16_t* p = Vt + ((2 * wave + dd) * 16 + r) * 132 + ks * 32 + fq * 8; bfr[dd][ks] = ld_pair(p, p + 4); }
#pragma unroll 1
    for (int dir = 0; dir < 2; ++dir) {
        const int si = (bh * 2 + dir) * 64 + c;
        __syncthreads();
        st_T<4, 128>(kreg, Kt, 132, we + dir * 128, tid);
        __syncthreads();
        if (tid < 128) { float sn = 0.f; const LAS bf16_t* kr = Kt + tid * 132;
            for (int q = 0; q < 128; q += 4) { const u32x2 wv = *(const LAS u32x2*)(kr + q); sn += (bflo(wv.x) + bfhi(wv.x)) + (bflo(wv.y) + bfhi(wv.y)); }
            nb[(size_t)si * 128 + tid] = sn; }
        bf16_t* Cg = Cb + (size_t)si * 256 * 128;
#pragma unroll
        for (int dkt = 0; dkt < 8; ++dkt) { f32x4 a0 = (f32x4){0.f, 0.f, 0.f, 0.f}, a1 = (f32x4){0.f, 0.f, 0.f, 0.f};
#pragma unroll
            for (int ks = 0; ks < 4; ++ks) { const LAS bf16_t* p = Kt + (dkt * 16 + r) * 132 + ks * 32 + fq * 8; const bf16x8 a = ld_pair(p, p + 4);
                a0 = MFMA16(a, bfr[0][ks], a0); a1 = MFMA16(a, bfr[1][ks], a1); }
            u32x2 w0; w0.x = cvt_pk_bf16(a0[0], a0[1]); w0.y = cvt_pk_bf16(a0[2], a0[3]);
            u32x2 w1; w1.x = cvt_pk_bf16(a1[0], a1[1]); w1.y = cvt_pk_bf16(a1[2], a1[3]);
            *(u32x2*)(Cg + (size_t)((2 * wave) * 16 + r) * 128 + dkt * 16 + 4 * fq) = w0;
            *(u32x2*)(Cg + (size_t)((2 * wave + 1) * 16 + r) * 128 + dkt * 16 + 4 * fq) = w1; }
    }
}

__device__ __forceinline__ void mlstm_scan(bf16_t* Cb, float* nb, const float* mloc, const float* gch, float* mprev, int tid) {
    for (int vb = blockIdx.x; vb < 256; vb += gridDim.x) {
        const int bhd = vb >> 4, part = vb & 15, dir = bhd & 1;
        bf16_t* Cp = Cb + (size_t)bhd * 64 * 32768 + (size_t)(part * 512 + tid) * 4;
        const bool do_n = (part == 0) && (tid < 128);
        float* np = nb + (size_t)bhd * 64 * 128 + (tid & 127);
        float c0 = 0.f, c1 = 0.f, c2 = 0.f, c3 = 0.f, cn = 0.f, m = -1.0e30f;
        for (int s0 = 0; s0 < 64; s0 += 8) {
            u32x2 v[8]; float gg[8], ml[8], nv[8];
#pragma unroll
            for (int q = 0; q < 8; ++q) { const int c = dir ? 63 - (s0 + q) : (s0 + q);
                v[q] = *(const u32x2*)(Cp + (size_t)c * 32768); gg[q] = gch[bhd * 64 + c]; ml[q] = mloc[bhd * 64 + c]; nv[q] = do_n ? np[c * 128] : 0.f; }
#pragma unroll
            for (int q = 0; q < 8; ++q) { const int c = dir ? 63 - (s0 + q) : (s0 + q);
                u32x2 o; o.x = cvt_pk_bf16(c0, c1); o.y = cvt_pk_bf16(c2, c3);
                *(u32x2*)(Cp + (size_t)c * 32768) = o;
                if (do_n) np[c * 128] = cn;
                if (part == 0 && tid == 0) mprev[bhd * 64 + c] = m;
                const float mn = fmaxf(gg[q] + m, ml[q]);
                const float sp = expf(gg[q] + m - mn), sl = expf(ml[q] - mn);
                c0 = sp * c0 + sl * bflo(v[q].x); c1 = sp * c1 + sl * bfhi(v[q].x); c2 = sp * c2 + sl * bflo(v[q].y); c3 = sp * c3 + sl * bfhi(v[q].y);
                cn = sp * cn + sl * nv[q];
                m = mn; }
        }
    }
}

__device__ __forceinline__ void mlstm_out_item(int item, bf16_t* proj, const bf16_t* qc, const bf16_t* kc, const float* gates, const float* gbias, const bf16_t* Cb, const float* nb,
                                               const float* mprev, const float* gnorm, LAS unsigned char* lds, int tid) {
    asm volatile("" : "+v"(tid));
    const int c = item & 63, h = (item >> 6) & 3, b = item >> 8;
    const int wave = tid >> 6, lane = tid & 63, r = lane & 15, fq = lane >> 4;
    const long row0 = (long)b * SEQ + c * 128;
    const int bh = b * 4 + h;
    LAS bf16_t* Ks = (LAS bf16_t*)lds;
    LAS bf16_t* Vt = (LAS bf16_t*)(lds + 34816);
    LAS float* fl = (LAS float*)(lds + 104448);
    LAS float* lf = fl; LAS float* li = fl + 256; LAS float* bb = fl + 512; LAS float* ee = fl + 768; LAS float* Mt = fl + 1024; LAS float* mpl = fl + 1280; LAS float* npv = fl + 1536;
    const int t = 16 * wave + r;
    float mpv = 0.f;
    { u32x4 kreg[4], vreg[8]; float gi = 0.f, gf = 0.f, nn = 0.f;
      ld_nat<4>(kc + row0 * 512 + h * 128, 512, 0, 128, tid, kreg);
      ld_T<8, 128>(proj + row0 * NPROJ + PC_MV + h * 256, NPROJ, 0, 128, tid, vreg);
      if (tid < 256) { const int dir = tid >> 7, l = tid & 127; const int si = (bh * 2 + dir) * 64 + c;
          gi = gates[(row0 + l) * 16 + (2 * dir) * 4 + h] + gbias[(2 * dir) * 4 + h];
          gf = gates[(row0 + l) * 16 + (2 * dir + 1) * 4 + h] + gbias[(2 * dir + 1) * 4 + h];
          nn = nb[(size_t)si * 128 + l]; mpv = mprev[si]; }
      __syncthreads();
      if (tid < 256) { li[tid] = gi; lf[tid] = logsigmoid_(gf); npv[tid] = nn; }
      st_nat<4>(kreg, Ks, tid);
      st_T<8, 128>(vreg, Vt, 136, nullptr, tid); }
    __syncthreads();
    if (tid < 256) { const int dir = tid >> 7, l = tid & 127; float acc = 0.f, tot = 0.f;
        for (int q = 0; q < 128; ++q) { const float v = lf[dir * 128 + q]; tot += v; acc += (q <= l) ? v : 0.f; }
        if (dir) acc = tot - acc + lf[dir * 128 + l];
        bb[tid] = acc; ee[tid] = li[tid] - acc; }
    __syncthreads();
    if (tid < 256) { const int dir = tid >> 7, l = tid & 127; float pmf = -3.0e38f, pmb = -3.0e38f;
        for (int q = 0; q < 128; ++q) { const float v = ee[dir * 128 + q]; pmf = fmaxf(pmf, (q <= l) ? v : -3.0e38f); pmb = fmaxf(pmb, (q >= l) ? v : -3.0e38f); }
        Mt[tid] = fmaxf(mpv, dir ? pmb : pmf);
        if (l == 0) mpl[dir] = mpv; }
    __syncthreads();
    bf16x8 qf[4];
    { const bf16_t* qr = qc + (row0 + t) * 512 + h * 128;
#pragma unroll
      for (int ks = 0; ks < 4; ++ks) qf[ks] = *(const bf16x8*)(qr + ks * 32 + fq * 8); }
    f32x4 sacc[8];
#pragma unroll
    for (int st = 0; st < 8; ++st) { f32x4 a4 = (f32x4){0.f, 0.f, 0.f, 0.f};
#pragma unroll
        for (int ks = 0; ks < 4; ++ks) { const bf16x8 a = *(const LAS bf16x8*)(Ks + (16 * st + r) * 136 + ks * 32 + fq * 8); a4 = MFMA16(a, qf[ks], a4); }
        sacc[st] = a4; }
    __syncthreads();
    LAS bf16_t* hsl = (LAS bf16_t*)(wave < 4 ? lds + wave * 8320 : lds + 111616 + (wave - 4) * 8320) + r * 260 + 4 * fq;
    bf16x8 pb[2][4]; float inv[2], wi[2];
    const int w = __builtin_amdgcn_readfirstlane(wave);
    const float L2E = 1.4426950408889634f;
#pragma unroll
    for (int dir = 0; dir < 2; ++dir) {
        const float Mv = Mt[dir * 128 + t]; const float mp = mpl[dir];
        const float winter = __builtin_amdgcn_exp2f((mp - Mv) * L2E);
        float qd = 0.f;
#pragma unroll
        for (int ks = 0; ks < 4; ++ks) { const LAS float* np = npv + dir * 128 + ks * 32 + fq * 8; const u32x4 qw = (u32x4)qf[ks];
            qd += bflo(qw.x) * np[0] + bfhi(qw.x) * np[1] + bflo(qw.y) * np[2] + bfhi(qw.y) * np[3] + bflo(qw.z) * np[4] + bfhi(qw.z) * np[5] + bflo(qw.w) * np[6] + bfhi(qw.w) * np[7]; }
        qd += __shfl_xor(qd, 16); qd += __shfl_xor(qd, 32);
        float den = 0.f; f32x4 pv[8];
#pragma unroll
        for (int st = 0; st < 8; ++st)
#pragma unroll
            for (int jj = 0; jj < 4; ++jj) { const int sidx = 16 * st + 4 * fq + jj; const bool valid = dir ? (sidx >= t) : (sidx <= t);
                const float wgt = valid ? __builtin_amdgcn_exp2f((ee[dir * 128 + sidx] - Mv) * L2E) : 0.f; const float p = sacc[st][jj] * wgt; den += p; pv[st][jj] = p; }
#pragma unroll
        for (int kp = 0; kp < 4; ++kp) pb[dir][kp] = pack8(pv[2 * kp], pv[2 * kp + 1]);
        den += __shfl_xor(den, 16); den += __shfl_xor(den, 32);
        const float dent = den + winter * qd;
        const float denom = fmaxf(fabsf(dent), expf(-(bb[dir * 128 + t] + Mv)));
        inv[dir] = 1.0f / denom; wi[dir] = winter;
    }
    float ss = 0.f;
    bf16_t* orow = proj + (size_t)(row0 + t) * NPROJ + PC_MO + h * 256;
    LAS bf16_t* SL = (LAS bf16_t*)(lds + 144896);
    const int srow = (tid >> 4) & 31, sc8 = tid & 15;
    const bf16_t* sg0 = Cb + (size_t)((bh * 2 + 0) * 64 + c) * 32768 + srow * 128 + sc8 * 8;
    const bf16_t* sg1 = Cb + (size_t)((bh * 2 + 1) * 64 + c) * 32768 + srow * 128 + sc8 * 8;
    LAS bf16_t* sdst = SL + srow * 136 + sc8 * 8;
    u32x4 pre0 = *(const u32x4*)sg0, pre1 = *(const u32x4*)sg1;
#pragma unroll 1
    for (int sl = 0; sl < 8; ++sl) {
        __syncthreads();
        *(LAS u32x4*)sdst = pre0; *(LAS u32x4*)(sdst + 32 * 136) = pre1;
        __syncthreads();
        { const int sn = sl < 7 ? sl + 1 : 7; pre0 = *(const u32x4*)(sg0 + (size_t)sn * 4096); pre1 = *(const u32x4*)(sg1 + (size_t)sn * 4096); }
#pragma unroll
        for (int d2 = 0; d2 < 2; ++d2) {
            const int dvt = sl * 2 + d2;
            f32x4 hsum = (f32x4){0.f, 0.f, 0.f, 0.f};
            const LAS bf16_t* vr = Vt + (dvt * 16 + r) * 136 + 4 * fq;
#pragma unroll
            for (int dir = 0; dir < 2; ++dir) {
                f32x4 a4 = (f32x4){0.f, 0.f, 0.f, 0.f};
                const LAS bf16_t* cr = SL + dir * (32 * 136) + (d2 * 16 + r) * 136 + fq * 8;
#pragma unroll
                for (int ks = 0; ks < 4; ++ks) { const bf16x8 a = *(const LAS bf16x8*)(cr + ks * 32); a4 = MFMA16(a, qf[ks], a4); }
                a4 = a4 * wi[dir];
#pragma unroll
                for (int kp = 0; kp < 4; ++kp) { const bf16x8 a = ld_pair(vr + kp * 32, vr + kp * 32 + 16); a4 = MFMA16(a, pb[dir][kp], a4); }
                hsum = hsum + a4 * inv[dir];
            }
            ss += (hsum[0] * hsum[0] + hsum[1] * hsum[1]) + (hsum[2] * hsum[2] + hsum[3] * hsum[3]);
            u32x2 w; w.x = cvt_pk_bf16(hsum[0], hsum[1]); w.y = cvt_pk_bf16(hsum[2], hsum[3]);
            *(LAS u32x2*)(hsl + dvt * 16) = w;
        }
    }
    ss += __shfl_xor(ss, 16); ss += __shfl_xor(ss, 32);
    const float rn = 1.0f / sqrtf(ss * (1.0f / 256.0f) + NORM_EPS);
#pragma unroll 8
    for (int dvt = 0; dvt < 16; ++dvt) { const int dv0 = dvt * 16 + 4 * fq;
        const f32x4 gg = *(const f32x4*)(gnorm + h * 256 + dv0);
        const u32x2 mo = *(const u32x2*)(orow + dv0);
        const u32x2 v = *(const LAS u32x2*)(hsl + dvt * 16);
        const float o0 = bflo(v.x) * rn * gg[0] * sigmoidf_(bflo(mo.x)), o1 = bfhi(v.x) * rn * gg[1] * sigmoidf_(bfhi(mo.x));
        const float o2 = bflo(v.y) * rn * gg[2] * sigmoidf_(bflo(mo.y)), o3 = bfhi(v.y) * rn * gg[3] * sigmoidf_(bfhi(mo.y));
        u32x2 w; w.x = cvt_pk_bf16(o0, o1); w.y = cvt_pk_bf16(o2, o3);
        *(u32x2*)(orow + dv0) = w; }
}


#define XB_TMO      128
#define XB_XCNT(j)  (256  + 64 * (j))
#define XB_XSUB(j)  (1280 + 64 * (j))
#define XB_XGEN(j)  (2304 + 64 * (j))
#define XB_TOP      3328
#define XB_TOPGEN   3392
#define XCD_BAR_WORDS 3456
#define XB_SPIN_CAP (1u << 20)
__device__ __forceinline__ unsigned xb_ld(unsigned* p)              { return __hip_atomic_load(p, __ATOMIC_RELAXED, __HIP_MEMORY_SCOPE_AGENT); }
__device__ __forceinline__ unsigned xb_add(unsigned* p, unsigned v) { return __hip_atomic_fetch_add(p, v, __ATOMIC_RELAXED, __HIP_MEMORY_SCOPE_AGENT); }
__device__ __forceinline__ unsigned xb_xcc_id() { return (unsigned)__builtin_amdgcn_s_getreg((3 << 11) | 20) & 0xFu; }
#define XB_SPIN(cond, bar) do { unsigned _sp = 0; while (cond) { __builtin_amdgcn_s_sleep(1); \
    if ((++_sp & 255u) == 0u) { if (xb_ld(&(bar)[XB_TMO])) break; if (_sp > XB_SPIN_CAP) { atomicAdd(&(bar)[XB_TMO], 1u); break; } } } } while (0)
struct XcdBarrier { unsigned* bar; unsigned x; volatile LAS unsigned* st; };
__device__ __forceinline__ XcdBarrier xcd_barrier_post(unsigned* bar, volatile LAS unsigned* st) {
    XcdBarrier b; b.bar = bar; b.x = xb_xcc_id(); b.st = st;
    if (threadIdx.x == 0) (void)xb_add(&bar[XB_XCNT(b.x)], 1u);
    return b;
}
__device__ __forceinline__ void xcd_barrier_complete(unsigned* bar, unsigned x, unsigned& nloc, unsigned& nx) {
    const unsigned G = gridDim.x * gridDim.y * gridDim.z;
    unsigned sum, cnt, mine, sp = 0u;
    for (;;) {
        sum = 0u; cnt = 0u; mine = 0u;
#pragma unroll
        for (unsigned j = 0; j < 16; ++j) { const unsigned c = xb_ld(&bar[XB_XCNT(j)]); sum += c; cnt += (c > 0u) ? 1u : 0u; mine = (j == x) ? c : mine; }
        if (sum == G) break;
        __builtin_amdgcn_s_sleep(1);
        if ((++sp & 255u) == 0u) { if (xb_ld(&bar[XB_TMO])) break; if (sp > XB_SPIN_CAP) { atomicAdd(&bar[XB_TMO], 1u); break; } }
    }
    nloc = mine > 0u ? mine : 1u; nx = cnt > 0u ? cnt : 1u;
}
__device__ __forceinline__ void xcd_barrier(const XcdBarrier& b) {
    asm volatile("s_waitcnt vmcnt(0)" ::: "memory");
    __syncthreads();
    if (threadIdx.x == 0) {
        unsigned* bar = b.bar;
        __builtin_amdgcn_s_waitcnt(0);
        unsigned nloc = b.st[0], nx = b.st[1];
        if (nloc == 0u) { xcd_barrier_complete(bar, b.x, nloc, nx); b.st[0] = nloc; b.st[1] = nx; }
        const unsigned old = xb_add(&bar[XB_XSUB(b.x)], 1u);
        const unsigned gen = old / nloc;
        if (old + 1u == (gen + 1u) * nloc) {
            __builtin_amdgcn_fence(__ATOMIC_RELEASE, "agent");
            asm volatile("s_waitcnt vmcnt(0)" ::: "memory");
            const unsigned og = xb_add(&bar[XB_TOP], 1u);
            const unsigned tg = og / nx;
            if (og + 1u == (tg + 1u) * nx) xb_add(&bar[XB_TOPGEN], 1u);
            else XB_SPIN(xb_ld(&bar[XB_TOPGEN]) == tg, bar);
            __builtin_amdgcn_fence(__ATOMIC_ACQUIRE, "agent");
            xb_add(&bar[XB_XGEN(b.x)], 1u);
            asm volatile("s_waitcnt vmcnt(0)" ::: "memory");
        } else {
            XB_SPIN(xb_ld(&bar[XB_XGEN(b.x)]) == gen, bar);
            __builtin_amdgcn_fence(__ATOMIC_ACQUIRE, "agent");
            asm volatile("s_waitcnt vmcnt(0)" ::: "memory");
        }
    }
    __syncthreads();
}

struct Args {
    const float* x; const float* w_in; const float* conv_w; const float* gate_bias; const float* ml_norm_g; const float* attn_sink; const float* w_out;
    const float* g_pre_mix; const float* g_post_mix; const float* g_pre_mlp; const float* g_post_mlp; const float* w_up; const float* w_down;
    float* out; unsigned char* ws; int ph_lo, ph_hi;
};

__global__ void __launch_bounds__(512, 2) mega(Args a) {
    extern __shared__ __attribute__((aligned(16))) unsigned char lds_raw[];
    LAS unsigned char* lds = (LAS unsigned char*)lds_raw;
    cg::grid_group grid = cg::this_grid();
    unsigned char* ws = a.ws;
    bf16_t* proj = (bf16_t*)(ws + WS_PROJ); bf16_t* qc = (bf16_t*)(ws + WS_QC); bf16_t* kc = (bf16_t*)(ws + WS_KC); bf16_t* Cb = (bf16_t*)(ws + WS_CB);
    float* gates = (float*)(ws + WS_GATES); float* nb = (float*)(ws + WS_NB); float* mloc = (float*)(ws + WS_ML); float* gch = (float*)(ws + WS_GC); float* mprev = (float*)(ws + WS_MP);
    bf16_t* ubuf = (bf16_t*)(ws + WS_U); bf16_t* mixA = (bf16_t*)(ws + WS_MIXO); bf16_t* mixB = (bf16_t*)(ws + WS_HB);
    bf16_t* hb = (bf16_t*)a.out;
    bf16_t* W0 = (bf16_t*)(ws + WS_W0); bf16_t* W1 = (bf16_t*)(ws + WS_W1); bf16_t* W2 = (bf16_t*)(ws + WS_W2);

    volatile LAS unsigned* xb_st = (volatile LAS unsigned*)(lds + LDS_BYTES - 16);
    if (threadIdx.x < 4) xb_st[threadIdx.x] = 0u;
    __syncthreads();
    XcdBarrier xbar = xcd_barrier_post((unsigned*)(ws + WS_BAR), xb_st);
    for (int ph = a.ph_lo; ph < a.ph_hi; ++ph) {
        int tid = threadIdx.x; asm volatile("" : "+v"(tid));
        const int lane = tid & 63, wave = __builtin_amdgcn_readfirstlane(tid >> 6);
        const int gw = blockIdx.x * 8 + wave, NGW = gridDim.x * 8;
        LAS float* scr = (LAS float*)(lds + wave * 16640);
        const int l = (ph == 0) ? 0 : (ph - 1) / 10, pt = (ph == 0) ? -1 : (ph - 1) % 10;
        if (ph == 0 && (PHMASK & 1)) {
            convert_win(a.w_in, W0, scr, lane, gw, NGW);
            convert_plain(a.w_out, DM, DM, W2, scr, lane, gw, NGW);
            row_phase(a.x, nullptr, nullptr, nullptr, nullptr, nullptr, a.g_pre_mix, hb, lane, gw, NGW);
        } else if ((PHMASK & 2) && (pt == 0 || pt == 5 || pt == 7 || pt == 8)) {
            pg8::Gemm g; pg8::Epi E; E.gates = gates; E.gate_pn = -1; E.act = 0;
            if (pt == 0)      { g = pg8::Gemm{hb, W0, T, NIN, DM, DM};      E.O = proj; E.ldc = NPROJ; E.gate_pn = 18; }
            else if (pt == 5) { g = pg8::Gemm{proj, W2, T, DM, DM, NPROJ};  E.O = mixA; E.ldc = DM; }
            else if (pt == 7) { g = pg8::Gemm{hb, W0, T, FF, DM, DM};       E.O = ubuf; E.ldc = LDU; E.act = 1; }
            else              { g = pg8::Gemm{ubuf, W1, T, DM, FF, LDU};    E.O = mixB; E.ldc = DM; }
            pg8::StaticOrder S; S.init(g.M, g.N, (int)gridDim.x, (int)blockIdx.x);
            pg8::gemm_phase(lds, g, S, E, tid);
            if (pt == 0) {
                const int rem = (T / 256) * (NIN / 256) % (int)gridDim.x;
                if (rem != 0 && (int)blockIdx.x >= rem) { __syncthreads();
                    convert_plain(a.w_down + (size_t)l * FF * DM, FF, DM, W1, scr, lane, ((int)blockIdx.x - rem) * 8 + wave, ((int)gridDim.x - rem) * 8); }
            }
        } else if ((PHMASK & 4) && pt == 1) {
            prep_phase(proj, a.conv_w + (size_t)l * 3 * 1024, qc, kc, lane, gw, NGW);
        } else if ((PHMASK & 8) && pt == 2) {
            for (int it = blockIdx.x; it < 1536; it += gridDim.x) {
                if (it < 1024) { if (PHMASK & 64) attn_item(it, proj, a.attn_sink + l * 8, lds, tid); }
                else mlstm_local_item(it - 1024, proj, kc, gates, a.gate_bias + l * 16, Cb, nb, mloc, gch, lds, tid);
            }
        } else if ((PHMASK & 16) && pt == 3) {
            mlstm_scan(Cb, nb, mloc, gch, mprev, tid);
        } else if ((PHMASK & 32) && pt == 4) {
            for (int it = blockIdx.x; it < 512; it += gridDim.x)
                mlstm_out_item(it, proj, qc, kc, gates, a.gate_bias + l * 16, Cb, nb, mprev, a.ml_norm_g + l * 1024, lds, tid);
        } else if ((PHMASK & 128) && pt == 6) {
            __syncthreads();
            convert_plain(a.w_up + (size_t)l * DM * FF, DM, FF, W0, scr, lane, gw, NGW);
            if ((T / 256) * (NIN / 256) % (int)gridDim.x == 0) convert_plain(a.w_down + (size_t)l * FF * DM, FF, DM, W1, scr, lane, gw, NGW);
            if (l == 0) row_phase(a.x, nullptr, mixA, a.g_post_mix, mixA, nullptr, a.g_pre_mlp, hb, lane, gw, NGW);
            else row_phase_b<3>(mixB, mixA, a.g_post_mix + DM, mixA, nullptr, a.g_pre_mlp + DM, hb, lane, gw, NGW);
        } else if (PHMASK & 256) {
            __syncthreads();
            if (l == 0) {
                convert_win(a.w_in + (size_t)DM * INCOLS, W0, scr, lane, gw, NGW);
                convert_plain(a.w_out + (size_t)DM * DM, DM, DM, W2, scr, lane, gw, NGW);
            }
            row_phase_b<3>(mixA, mixB, a.g_post_mlp + l * DM, l == 0 ? mixB : nullptr, l == 0 ? nullptr : a.out, l == 0 ? a.g_pre_mix + DM : nullptr, hb, lane, gw, NGW);
        }
        if (ph + 1 < a.ph_hi) { if (a.ph_hi > 1000) grid.sync(); else xcd_barrier(xbar); }
    }
}


#ifndef DBG_NPH
#define DBG_NPH 0
#endif
#if DBG_NPH
__global__ void dbg_dump(const unsigned short* src, size_t n, float* out, int nout) {
    for (size_t i = (size_t)blockIdx.x * blockDim.x + threadIdx.x; i < (size_t)nout; i += (size_t)gridDim.x * blockDim.x) {
        float s = 0.f;
        for (int k = 0; k < 4; ++k) { const size_t j = 4 * i + k; if (j < n) { const unsigned short b = src[j]; if ((b & 0x7f80u) == 0x7f80u) { const int col = (int)(j % 4608); s = col < 1024 ? 1.0e6f : (col < 2048 ? 3.0e6f : 7.0e6f); } } }
        out[i] = s; }
}
#endif
extern "C" void kernel_launch(void* const* d_in, const int* in_sizes, int n_in, void* d_out, int out_size, void* d_ws, size_t ws_size, hipStream_t stream) {
    static int grid = 0;
    if (grid == 0) {
        int dev = 0, cus = 0, per_cu = 0;
        (void)hipGetDevice(&dev);
        (void)hipDeviceGetAttribute(&cus, hipDeviceAttributeMultiprocessorCount, dev);
        if (hipFuncSetAttribute((const void*)mega, hipFuncAttributeMaxDynamicSharedMemorySize, LDS_BYTES) != hipSuccess) fprintf(stderr, "kernel_launch: hipFuncSetAttribute failed\n");
        if (hipOccupancyMaxActiveBlocksPerMultiprocessor(&per_cu, (const void*)mega, 512, LDS_BYTES) != hipSuccess || per_cu < 1) { fprintf(stderr, "kernel_launch: occupancy query says %d\n", per_cu); per_cu = 1; }
        (void)hipGetLastError();
        if (cus <= 0) cus = 256;
        grid = cus;
        if (ws_size < WS_END) fprintf(stderr, "kernel_launch: workspace too small: %zu < %zu\n", ws_size, (size_t)WS_END);
    }
    Args a{};
    a.x = (const float*)d_in[0]; a.w_in = (const float*)d_in[1]; a.conv_w = (const float*)d_in[2]; a.gate_bias = (const float*)d_in[3]; a.ml_norm_g = (const float*)d_in[4];
    a.attn_sink = (const float*)d_in[5]; a.w_out = (const float*)d_in[6]; a.g_pre_mix = (const float*)d_in[7]; a.g_post_mix = (const float*)d_in[8]; a.g_pre_mlp = (const float*)d_in[9];
    a.g_post_mlp = (const float*)d_in[10]; a.w_up = (const float*)d_in[11]; a.w_down = (const float*)d_in[12];
    a.out = (float*)d_out; a.ws = (unsigned char*)d_ws;
#if ONE_LAUNCH
    (void)hipMemsetAsync((unsigned char*)d_ws + WS_BAR, 0, 16384, stream);
    a.ph_lo = 0; a.ph_hi = NPH;
    void* args[] = {&a};
    hipError_t e = hipLaunchCooperativeKernel((const void*)mega, dim3(grid), dim3(512), args, LDS_BYTES, stream);
    if (e != hipSuccess) fprintf(stderr, "cooperative launch failed: %s (grid %d)\n", hipGetErrorString(e), grid);
#else
#if DBG_NPH
    for (int p = 0; p < DBG_NPH; ++p) { a.ph_lo = p; a.ph_hi = p + 1; hipLaunchKernelGGL(mega, dim3(grid), dim3(512), LDS_BYTES, stream, a); }
    hipLaunchKernelGGL(dbg_dump, dim3(2048), dim3(256), 0, stream, (const unsigned short*)((const unsigned char*)d_ws + DBG_OFF), (size_t)DBG_N, (float*)d_out, out_size);
#else
    for (int p = 0; p < NPH; ++p) { a.ph_lo = p; a.ph_hi = p + 1; hipLaunchKernelGGL(mega, dim3(grid), dim3(512), LDS_BYTES, stream, a); }
#endif
#endif
}
```
